# Optimizing an MI355X kernel written in HIP

```python
import jax, jax.numpy as jnp
from jax import lax
import numpy as np

D_MODEL = 2048
BATCH = 16
SEQ = 256
DEPTH = 2
DEC_BATCH = 8
DEC_SEQ = 4096
PAST_LEN = 256

GRID_W = 64
EPS = 1e-6
N_HEADS = 16
QK_NOPE = 64
QK_ROPE = 32
QK_HEAD = QK_NOPE + QK_ROPE
V_HEAD = 64
Q_LORA = 768
KV_LORA = 256
ROPE_THETA = 10000.0
AXIS_FREQS = QK_ROPE // 4
Q_BLOCK = 128
ATTN_SCALE = QK_HEAD ** -0.5
ATTN_W = N_HEADS * V_HEAD
POOL_WINDOWS = (2, 4, 8, 16)
POOL_GROUP_W = 128
POOL_W = POOL_GROUP_W * len(POOL_WINDOWS)
CHUNK = 128
SGU_GROUPS = 4
SGU_W = 512
SGU_GROUP_W = SGU_W // SGU_GROUPS
CONV_W = 512
CONV_K = 3
N_BRANCH = 4
D_FF = -(-8 * D_MODEL // (3 * 256)) * 256
OFF_CKV = Q_LORA
OFF_KPE = OFF_CKV + KV_LORA
OFF_POOL = OFF_KPE + QK_ROPE
OFF_SGU = OFF_POOL + POOL_W
OFF_CONV = OFF_SGU + 2 * SGU_W
OFF_GATE = OFF_CONV + 3 * CONV_W
N_IN = OFF_GATE + N_BRANCH * D_MODEL

kernel_name = "hybrid_diffusion_prefix_mla_pool_sgu_conv_step"


def rmsnorm(x, w):
    xf = x.astype(jnp.float32)
    y = xf * lax.rsqrt(jnp.mean(xf * xf, axis=-1, keepdims=True) + EPS)
    return (y * w.astype(jnp.float32)).astype(x.dtype)


def ada_params(cond, w_mod, b_mod):
    m = jax.nn.silu(cond) @ w_mod + b_mod
    m = m.reshape(m.shape[:-1] + (6, D_MODEL))
    return [m[..., i, :] for i in range(6)]


def modulate(x, norm_w, shift, scale):
    return rmsnorm(x, norm_w) * (1 + scale) + shift


def axial_rope_tables(T):
    rows = T // GRID_W
    row = jnp.repeat(jnp.arange(rows), GRID_W).astype(jnp.float32)
    col = jnp.tile(jnp.arange(GRID_W), rows).astype(jnp.float32)
    inv = ROPE_THETA ** (-jnp.arange(AXIS_FREQS, dtype=jnp.float32) / AXIS_FREQS)
    ang_r = row[:, None] * inv
    ang_c = col[:, None] * inv
    ang = jnp.stack([ang_r, ang_r, ang_c, ang_c], axis=1).reshape(T, QK_ROPE)
    return jnp.cos(ang), jnp.sin(ang)


def rope_rotary_part(x, cos, sin):
    xr = x[..., QK_NOPE:].astype(jnp.float32)
    xa = xr.reshape(xr.shape[:-1] + (2, 2, AXIS_FREQS))
    rot = jnp.stack([-xa[..., 1, :], xa[..., 0, :]], axis=-2).reshape(xr.shape)
    xr = xr * cos[None, :, None, :] + rot * sin[None, :, None, :]
    return jnp.concatenate([x[..., :QK_NOPE], xr.astype(x.dtype)], axis=-1)


def mla_latents(z, lw):
    c_q = rmsnorm(z[..., :OFF_CKV], lw["q_a_norm_w"])
    c_kv = rmsnorm(z[..., OFF_CKV:OFF_KPE], lw["kv_a_norm_w"])
    k_pe = z[..., OFF_KPE:OFF_POOL]
    return c_q, c_kv, k_pe


def mla_queries(c_q, w_uq, q_norm_w):
    B, T, _ = c_q.shape
    q = (c_q @ w_uq).reshape(B, T, N_HEADS, QK_HEAD)
    return rmsnorm(q, q_norm_w)


def mla_keys_values(c_kv, k_pe, w_ukv, k_norm_w):
    B, T, _ = c_kv.shape
    kv = (c_kv @ w_ukv).reshape(B, T, N_HEADS, QK_NOPE + V_HEAD)
    k_nope, v = kv[..., :QK_NOPE], kv[..., QK_NOPE:]
    k_rope = jnp.broadcast_to(k_pe[:, :, None, :], (B, T, N_HEADS, QK_ROPE))
    k = rmsnorm(jnp.concatenate([k_nope, k_rope], axis=-1), k_norm_w)
    return k, v


def attend_block(qb, k, v):
    s = jnp.einsum("bqhd,bkhd->bhqk", qb, k).astype(jnp.float32) * ATTN_SCALE
    p = jax.nn.softmax(s, axis=-1)
    return jnp.einsum("bhqk,bkhv->bqhv", p.astype(v.dtype), v)


def attend_blocked(q, k, v):
    B, T, H, Dh = q.shape
    nb = T // Q_BLOCK
    qb = q.reshape(B, nb, Q_BLOCK, H, Dh).transpose(1, 0, 2, 3, 4)
    ob = lax.map(lambda qi: attend_block(qi, k, v), qb)
    return ob.transpose(1, 0, 2, 3, 4).reshape(B, T, H * V_HEAD)


def multi_scale_pool(xp, w_pool, pool_scale):
    B, T, C = xp.shape
    xf = xp.astype(jnp.float32)
    S = jnp.concatenate([jnp.zeros((B, 1, C), jnp.float32), jnp.cumsum(xf, axis=1)], axis=1)
    t = jnp.arange(T)
    outs = []
    for g, w in enumerate(POOL_WINDOWS):
        lo = jnp.clip(t - w // 2, 0, T - 1)
        hi = jnp.clip(t + w // 2 - 1, 0, T - 1)
        sl = slice(g * POOL_GROUP_W, (g + 1) * POOL_GROUP_W)
        Sg = S[..., sl]
        cnt = (hi - lo + 1).astype(jnp.float32)[None, :, None]
        pooled = (Sg[:, hi + 1] - Sg[:, lo]) / cnt - xf[..., sl]
        outs.append(pooled.astype(xp.dtype) @ w_pool[g])
    return jnp.concatenate(outs, axis=-1) * pool_scale


def spatial_gating(zs, sgu_norm_w, w_spatial, b_spatial):
    zs = jax.nn.gelu(zs)
    u, v = zs[..., :SGU_W], zs[..., SGU_W:]
    v = rmsnorm(v, sgu_norm_w)
    B, T, _ = v.shape
    vc = v.reshape(B, T // CHUNK, CHUNK, SGU_GROUPS, SGU_GROUP_W)
    mixed = jnp.einsum("gqp,bnpgc->bnqgc", w_spatial, vc) + b_spatial.T[:, :, None]
    return u * mixed.reshape(B, T, SGU_W)


def short_conv(zc, conv_w):
    b_g = zc[..., :CONV_W]
    c_g = zc[..., CONV_W:2 * CONV_W]
    xc = zc[..., 2 * CONV_W:]
    y = c_g * xc
    yp = jnp.pad(y, ((0, 0), (1, 1), (0, 0)))
    conv = conv_w[0] * yp[:, :-2] + conv_w[1] * yp[:, 1:-1] + conv_w[2] * yp[:, 2:]
    return b_g * conv


def local_branches(z, lw):
    pool_o = multi_scale_pool(z[..., OFF_POOL:OFF_SGU], lw["w_pool"], lw["pool_scale"])
    sgu_o = spatial_gating(z[..., OFF_SGU:OFF_CONV], lw["sgu_norm_w"], lw["w_spatial"], lw["b_spatial"])
    conv_o = short_conv(z[..., OFF_CONV:OFF_GATE], lw["conv_w"])
    return pool_o, sgu_o, conv_o


def merge_branches(z, attn_o, pool_o, sgu_o, conv_o, lw):
    B, T, _ = z.shape
    g = jax.nn.sigmoid(z[..., OFF_GATE:] + lw["b_gate"]).reshape(B, T, N_BRANCH, D_MODEL)
    m = (g[..., 0, :] * (attn_o @ lw["w_br_attn"]) + g[..., 1, :] * (pool_o @ lw["w_br_pool"])
         + g[..., 2, :] * (sgu_o @ lw["w_br_sgu"]) + g[..., 3, :] * (conv_o @ lw["w_br_conv"]))
    return m @ lw["w_out"]


def swiglu(h, w_ffn_in, w_ffn_out):
    a = h @ w_ffn_in
    return (jax.nn.silu(a[..., :D_FF]) * a[..., D_FF:]) @ w_ffn_out


def context_layer(x, c_ctx, lw):
    sh_a, sc_a, g_a, sh_f, sc_f, g_f = ada_params(c_ctx, lw["w_mod"], lw["b_mod"])
    h = modulate(x, lw["norm_mix_w"], sh_a, sc_a)
    z = h @ lw["w_in"]
    c_q, c_kv, k_pe = mla_latents(z, lw)
    q = mla_queries(c_q, lw["w_uq"], lw["q_norm_w"])
    k, v = mla_keys_values(c_kv, k_pe, lw["w_ukv"], lw["k_norm_w"])
    attn_o = attend_blocked(q, k, v)
    mix = merge_branches(z, attn_o, *local_branches(z, lw), lw)
    x = x + g_a * mix
    x = x + g_f * swiglu(modulate(x, lw["norm_ffn_w"], sh_f, sc_f), lw["w_ffn_in"], lw["w_ffn_out"])
    return x, c_kv, k_pe


def latent_layer(x, cond, ckv_ctx, kpe_ctx, lw, cos, sin):
    sh_a, sc_a, g_a, sh_f, sc_f, g_f = ada_params(cond[:, None, :], lw["w_mod"], lw["b_mod"])
    h = modulate(x, lw["norm_mix_w"], sh_a, sc_a)
    z = h @ lw["w_in"]
    c_q, c_kv, k_pe = mla_latents(z, lw)
    q = rope_rotary_part(mla_queries(c_q, lw["w_uq"], lw["q_norm_w"]), cos, sin)
    k, v = mla_keys_values(c_kv, k_pe, lw["w_ukv"], lw["k_norm_w"])
    k = rope_rotary_part(k, cos, sin)
    k_c, v_c = mla_keys_values(ckv_ctx, kpe_ctx, lw["w_ukv"], lw["k_norm_w"])
    k_all = jnp.concatenate([k, k_c.astype(k.dtype)], axis=1)
    v_all = jnp.concatenate([v, v_c.astype(v.dtype)], axis=1)
    attn_o = attend_blocked(q, k_all, v_all)
    mix = merge_branches(z, attn_o, *local_branches(z, lw), lw)
    x = x + g_a * mix
    x = x + g_f * swiglu(modulate(x, lw["norm_ffn_w"], sh_f, sc_f), lw["w_ffn_in"], lw["w_ffn_out"])
    return x


def setup_inputs(seed: int = 0) -> dict:
    key = jax.random.key(seed)
    ks = iter(jax.random.split(key, 40))
    f32 = jnp.float32

    def nrm(shape, scale):
        return jax.random.normal(next(ks), shape, f32) * scale

    def gain(shape):
        return 1.0 + 0.02 * jax.random.normal(next(ks), shape, f32)

    L = DEPTH
    return {
        "x_prompt": nrm((BATCH, SEQ, D_MODEL), 1.0),
        "x_sample": nrm((DEC_BATCH, DEC_SEQ, D_MODEL), 1.0),
        "cache_ckv": nrm((DEC_BATCH, DEPTH, PAST_LEN, KV_LORA), 1.0),
        "cache_kpe": nrm((DEC_BATCH, DEPTH, PAST_LEN, QK_ROPE), 1.0),
        "c": nrm((DEC_BATCH, D_MODEL), 1.0),
        "c_ctx": nrm((D_MODEL,), 1.0),
        "w_mod": nrm((L, D_MODEL, 6 * D_MODEL), 0.5 * D_MODEL ** -0.5),
        "b_mod": nrm((L, 6 * D_MODEL), 0.02),
        "norm_mix_w": gain((L, D_MODEL)),
        "norm_ffn_w": gain((L, D_MODEL)),
        "w_in": nrm((L, D_MODEL, N_IN), D_MODEL ** -0.5),
        "b_gate": nrm((L, N_BRANCH * D_MODEL), 0.02),
        "q_a_norm_w": gain((L, Q_LORA)),
        "kv_a_norm_w": gain((L, KV_LORA)),
        "w_uq": nrm((L, Q_LORA, N_HEADS * QK_HEAD), Q_LORA ** -0.5),
        "w_ukv": nrm((L, KV_LORA, N_HEADS * (QK_NOPE + V_HEAD)), KV_LORA ** -0.5),
        "q_norm_w": gain((L, QK_HEAD)),
        "k_norm_w": gain((L, QK_HEAD)),
        "w_pool": nrm((L, len(POOL_WINDOWS), POOL_GROUP_W, POOL_GROUP_W), POOL_GROUP_W ** -0.5),
        "pool_scale": gain((L, POOL_W)),
        "sgu_norm_w": gain((L, SGU_W)),
        "w_spatial": nrm((L, SGU_GROUPS, CHUNK, CHUNK), CHUNK ** -0.5),
        "b_spatial": gain((L, SGU_GROUPS, CHUNK)),
        "conv_w": nrm((L, CONV_K, CONV_W), CONV_K ** -0.5),
        "w_br_attn": nrm((L, ATTN_W, D_MODEL), ATTN_W ** -0.5),
        "w_br_pool": nrm((L, POOL_W, D_MODEL), POOL_W ** -0.5),
        "w_br_sgu": nrm((L, SGU_W, D_MODEL), SGU_W ** -0.5),
        "w_br_conv": nrm((L, CONV_W, D_MODEL), CONV_W ** -0.5),
        "w_out": nrm((L, D_MODEL, D_MODEL), D_MODEL ** -0.5),
        "w_ffn_in": nrm((L, D_MODEL, 2 * D_FF), D_MODEL ** -0.5),
        "w_ffn_out": nrm((L, D_FF, D_MODEL), D_FF ** -0.5),
    }


def reference(x_prompt, x_sample, cache_ckv, cache_kpe, c, c_ctx, w_mod, b_mod, norm_mix_w, norm_ffn_w,
              w_in, b_gate, q_a_norm_w, kv_a_norm_w, w_uq, w_ukv, q_norm_w, k_norm_w, w_pool, pool_scale,
              sgu_norm_w, w_spatial, b_spatial, conv_w, w_br_attn, w_br_pool, w_br_sgu, w_br_conv, w_out,
              w_ffn_in, w_ffn_out):
    cos, sin = axial_rope_tables(x_sample.shape[1])
    xp = x_prompt
    xs = x_sample
    ckv_list = []
    kpe_list = []
    for l in range(DEPTH):
        lw = dict(w_mod=w_mod[l], b_mod=b_mod[l], norm_mix_w=norm_mix_w[l], norm_ffn_w=norm_ffn_w[l],
                  w_in=w_in[l], b_gate=b_gate[l], q_a_norm_w=q_a_norm_w[l], kv_a_norm_w=kv_a_norm_w[l],
                  w_uq=w_uq[l], w_ukv=w_ukv[l], q_norm_w=q_norm_w[l], k_norm_w=k_norm_w[l],
                  w_pool=w_pool[l], pool_scale=pool_scale[l], sgu_norm_w=sgu_norm_w[l],
                  w_spatial=w_spatial[l], b_spatial=b_spatial[l], conv_w=conv_w[l],
                  w_br_attn=w_br_attn[l], w_br_pool=w_br_pool[l], w_br_sgu=w_br_sgu[l],
                  w_br_conv=w_br_conv[l], w_out=w_out[l], w_ffn_in=w_ffn_in[l], w_ffn_out=w_ffn_out[l])
        xp, ckv_l, kpe_l = context_layer(xp, c_ctx, lw)
        ckv_list.append(ckv_l)
        kpe_list.append(kpe_l)
        xs = latent_layer(xs, c, cache_ckv[:, l], cache_kpe[:, l], lw, cos, sin)
    state_ckv = jnp.stack(ckv_list, axis=1)
    state_kpe = jnp.stack(kpe_list, axis=1)
    return (xp, xs, state_ckv, state_kpe)
```

```cpp
#include <hip/hip_runtime.h>
#include <cstdio>
#include <cstdint>

#define LAS __attribute__((address_space(3)))
#define GAS __attribute__((address_space(1)))
typedef unsigned short bf16_t;
typedef short bf16x8 __attribute__((ext_vector_type(8)));
typedef float f32x2 __attribute__((ext_vector_type(2)));
typedef float f32x4 __attribute__((ext_vector_type(4)));
typedef float f32x16 __attribute__((ext_vector_type(16)));
typedef unsigned u32x2 __attribute__((ext_vector_type(2)));
typedef unsigned u32x4 __attribute__((ext_vector_type(4)));

#ifndef WGM_BIG
#define WGM_BIG 4
#endif
#ifndef WGM_SMALL
#define WGM_SMALL 4
#endif
#ifndef ATT_BIG
#define ATT_BIG 1.0995116e12f
#define ATT_CHK 1.0e37f
#endif
#ifndef MK_MULTI
#define MK_MULTI 0
#endif

constexpr int DM = 2048, TCTX = 4096, TLAT = 32768, TALL = TCTX + TLAT, NINW = 12320, DFF = 5632;
constexpr int NH = 16, QKH = 96, VH = 64, QLORA = 768, KVL = 256, ROPE = 32;
constexpr float EPS = 1e-6f;
constexpr int NLAYER = 2, NCOND = 9, NGRP = 3;
constexpr int GROWS = 16384, GKV = 17408;
constexpr int NWG = 256, NTHR = 512, NWAVE = 8;

constexpr size_t MiB = 1u << 20;
constexpr size_t WS_CTL = 0, CTL_BYTES = 1 * MiB;
constexpr size_t WS_MOD = 1 * MiB;
constexpr size_t WS_W0 = 2 * MiB;
constexpr size_t OFF_WIN = 0;
constexpr size_t OFF_WKPE = OFF_WIN + (size_t)12288 * 2048 * 2;
constexpr size_t OFF_WUQ = OFF_WKPE + (size_t)32 * 2048 * 2;
constexpr size_t OFF_WUK = OFF_WUQ + (size_t)1536 * 768 * 2;
constexpr size_t OFF_WUV = OFF_WUK + (size_t)1024 * 256 * 2;
constexpr size_t OFF_WSP = OFF_WUV + (size_t)1024 * 256 * 2;
constexpr size_t OFF_WBR = OFF_WSP + (size_t)4 * 128 * 128 * 2;
constexpr size_t OFF_WOUT = OFF_WBR + (size_t)2048 * 2560 * 2;
constexpr size_t OFF_WFI = OFF_WOUT + (size_t)2048 * 2048 * 2;
constexpr size_t OFF_WFO = OFF_WFI + (size_t)11264 * 2048 * 2;
constexpr size_t WL_BYTES = OFF_WFO + (size_t)2048 * 5632 * 2;
constexpr size_t WS_H = WS_W0 + WL_BYTES;
constexpr size_t WS_KPE = WS_H + (size_t)TALL * DM * 2;
constexpr size_t WS_G = WS_KPE + (size_t)TALL * 32 * 2;
constexpr size_t G_Z = 0;
constexpr size_t G_GATE = G_Z + (size_t)GROWS * 4096 * 2;
constexpr size_t G_Q = G_GATE + (size_t)GROWS * 8192;
constexpr size_t G_CKV = G_Q + (size_t)GROWS * 1536 * 2;
constexpr size_t G_KN = G_CKV + (size_t)GKV * 256 * 2;
constexpr size_t G_K = G_KN + (size_t)GKV * 1024 * 2;
constexpr size_t G_VT = G_K + (size_t)GKV * 1536 * 2;
constexpr size_t G_RQ = G_VT + (size_t)1024 * GKV * 2;
constexpr size_t G_BR = G_RQ + (size_t)GROWS * 4;
constexpr size_t G_M = G_BR + (size_t)GROWS * 2560 * 2;
constexpr size_t G_SCR = G_M + (size_t)GROWS * 2048 * 2;
constexpr size_t G_END = G_SCR;
constexpr size_t WS_ACT = WS_G;
static_assert((size_t)TALL * DFF * 2 <= G_END, "act overlay");
constexpr size_t WS_XB = WS_G + G_END;
constexpr size_t WS_END = WS_XB + (size_t)TALL * DM * 2;
static_assert(WS_END <= (size_t)1073741824, "workspace");
static_assert(WS_H % 256 == 0 && WS_G % 256 == 0 && G_SCR % 256 == 0 && OFF_WFO % 256 == 0 && WS_XB % 256 == 0, "align");

constexpr int LDS_MISC = 131072;
constexpr int LDS_BYTES = 147456;

typedef __bf16 bf16x2_t __attribute__((ext_vector_type(2)));
__device__ __forceinline__ unsigned cvt_pk_bf16(float lo, float hi) { const f32x2 v = {lo, hi}; const bf16x2_t b = __builtin_convertvector(v, bf16x2_t); return __builtin_bit_cast(unsigned, b); }
__device__ __forceinline__ float bf_lo(unsigned w) { return __uint_as_float(w << 16); }
__device__ __forceinline__ float bf_hi(unsigned w) { return __uint_as_float(w & 0xffff0000u); }
__device__ __forceinline__ float bf1(bf16_t b) { return __uint_as_float(((unsigned)b) << 16); }
template <int CTRL> __device__ __forceinline__ float dpp_f(float v) { return __builtin_bit_cast(float, __builtin_amdgcn_update_dpp(0, __builtin_bit_cast(int, v), CTRL, 0xf, 0xf, true)); }
__device__ __forceinline__ float quad_sum(float v) { v += dpp_f<0xB1>(v); v += dpp_f<0x4E>(v); return v; }
__device__ __forceinline__ float wave_sum(float v) {
    v = quad_sum(v);
    v += dpp_f<0x141>(v);
    v += dpp_f<0x140>(v);
    { auto rr = __builtin_amdgcn_permlane16_swap(__float_as_uint(v), __float_as_uint(v), false, false); v = __uint_as_float(rr[0]) + __uint_as_float(rr[1]); }
    { auto rr = __builtin_amdgcn_permlane32_swap(__float_as_uint(v), __float_as_uint(v), false, false); v = __uint_as_float(rr[0]) + __uint_as_float(rr[1]); }
    return v;
}
__device__ __forceinline__ float sigmoidf_(float x) { return __builtin_amdgcn_rcpf(1.0f + __expf(-x)); }
__device__ __forceinline__ float gelu_tanh(float x) {
    const float y2 = 1.5957691216057308f * (x + 0.044715f * x * x * x);
    return x * __builtin_amdgcn_rcpf(1.0f + __expf(-y2));
}
__device__ __forceinline__ void load8(const bf16_t* p, float (&v)[8]) { const u32x4 w = *(const u32x4*)p; v[0] = bf_lo(w.x); v[1] = bf_hi(w.x); v[2] = bf_lo(w.y); v[3] = bf_hi(w.y); v[4] = bf_lo(w.z); v[5] = bf_hi(w.z); v[6] = bf_lo(w.w); v[7] = bf_hi(w.w); }
__device__ __forceinline__ void store8(bf16_t* p, const float (&v)[8]) { u32x4 w; w.x = cvt_pk_bf16(v[0], v[1]); w.y = cvt_pk_bf16(v[2], v[3]); w.z = cvt_pk_bf16(v[4], v[5]); w.w = cvt_pk_bf16(v[6], v[7]); *(u32x4*)p = w; }
#define LDS_WAIT() asm volatile("s_waitcnt lgkmcnt(0)" ::: "memory")
#define VM_WAIT() asm volatile("s_waitcnt vmcnt(0)" ::: "memory")

#define XB_TMO      128
#define XB_XCNT(j)  (256  + 64 * (j))
#define XB_XSUB(j)  (1280 + 64 * (j))
#define XB_XGEN(j)  (2304 + 64 * (j))
#define XB_TOP      3328
#define XB_TOPGEN   3392
#define XCD_BAR_WORDS 3456
#define XB_SPIN_CAP (1u << 18)
__device__ __forceinline__ unsigned xb_ld(unsigned* p)              { return __hip_atomic_load(p, __ATOMIC_RELAXED, __HIP_MEMORY_SCOPE_AGENT); }
__device__ __forceinline__ unsigned xb_add(unsigned* p, unsigned v) { return __hip_atomic_fetch_add(p, v, __ATOMIC_RELAXED, __HIP_MEMORY_SCOPE_AGENT); }
__device__ __forceinline__ unsigned xb_xcc_id() { return (unsigned)__builtin_amdgcn_s_getreg((3 << 11) | 20) & 0xFu; }
#define XB_SPIN(cond, bar) do { unsigned _sp = 0; while (cond) { __builtin_amdgcn_s_sleep(1); \
    if ((++_sp & 255u) == 0u) { if (xb_ld(&(bar)[XB_TMO])) break; if (_sp > XB_SPIN_CAP) { atomicAdd(&(bar)[XB_TMO], 1u); break; } } } } while (0)
struct XcdBarrier { unsigned* bar; unsigned x; volatile LAS unsigned* st; };
__device__ __forceinline__ XcdBarrier xcd_barrier_post(unsigned* bar, volatile LAS unsigned* st) {
    XcdBarrier b; b.bar = bar; b.x = xb_xcc_id(); b.st = st;
    if (threadIdx.x == 0) (void)xb_add(&bar[XB_XCNT(b.x)], 1u);
    return b;
}
__device__ __forceinline__ void xcd_barrier_complete(unsigned* bar, unsigned x, unsigned& nloc, unsigned& nx) {
    const unsigned G = gridDim.x * gridDim.y * gridDim.z;
    unsigned sum, cnt, mine, sp = 0u;
    for (;;) {
        sum = 0u; cnt = 0u; mine = 0u;
#pragma unroll
        for (unsigned j = 0; j < 16; ++j) { const unsigned c = xb_ld(&bar[XB_XCNT(j)]); sum += c; cnt += (c > 0u) ? 1u : 0u; mine = (j == x) ? c : mine; }
        if (sum == G) break;
        __builtin_amdgcn_s_sleep(1);
        if ((++sp & 255u) == 0u) { if (xb_ld(&bar[XB_TMO])) break; if (sp > XB_SPIN_CAP) { atomicAdd(&bar[XB_TMO], 1u); break; } }
    }
    nloc = mine > 0u ? mine : 1u; nx = cnt > 0u ? cnt : 1u;
}
__device__ __forceinline__ void xcd_barrier(const XcdBarrier& b) {
    asm volatile("s_waitcnt vmcnt(0)" ::: "memory");
    __syncthreads();
    if (threadIdx.x == 0) {
        unsigned* bar = b.bar;
        __builtin_amdgcn_s_waitcnt(0);
        unsigned nloc = b.st[0], nx = b.st[1];
        if (nloc == 0u) { xcd_barrier_complete(bar, b.x, nloc, nx); b.st[0] = nloc; b.st[1] = nx; }
        const unsigned old = xb_add(&bar[XB_XSUB(b.x)], 1u);
        const unsigned gen = old / nloc;
        if (old + 1u == (gen + 1u) * nloc) {
            __builtin_amdgcn_fence(__ATOMIC_RELEASE, "agent");
            asm volatile("s_waitcnt vmcnt(0)" ::: "memory");
            const unsigned og = xb_add(&bar[XB_TOP], 1u);
            const unsigned tg = og / nx;
            if (og + 1u == (tg + 1u) * nx) xb_add(&bar[XB_TOPGEN], 1u);
            else XB_SPIN(xb_ld(&bar[XB_TOPGEN]) == tg, bar);
            __builtin_amdgcn_fence(__ATOMIC_ACQUIRE, "agent");
            xb_add(&bar[XB_XGEN(b.x)], 1u);
            asm volatile("s_waitcnt vmcnt(0)" ::: "memory");
        } else {
            XB_SPIN(xb_ld(&bar[XB_XGEN(b.x)]) == gen, bar);
            __builtin_amdgcn_fence(__ATOMIC_ACQUIRE, "agent");
            asm volatile("s_waitcnt vmcnt(0)" ::: "memory");
        }
    }
    __syncthreads();
}

namespace pg8 {
constexpr int BM = 256, BK = 64, HALF = 128, HTB = HALF * BK * 2, STAGE_BYTES = 8 * HTB, NXCD = 8;
__host__ __device__ __forceinline__ int lds_byte(int r, int c) { const int st = (r >> 4) * 2 + (c >> 5), rr = r & 15, cc = c & 31, ob = rr * 64 + cc * 2; return st * 1024 + (ob ^ (((ob >> 9) & 1) << 5)); }
__host__ __device__ __forceinline__ void stage_rc(int b, int& R, int& C) { const int st = b / 1024, sb = b % 1024, swz = sb ^ (((sb >> 9) & 1) << 5); R = (st >> 1) * 16 + swz / 64; C = (st & 1) * 32 + (swz % 64) / 2; }
__host__ __device__ __forceinline__ int perm32(int rho) { const int n = rho >> 4, i = rho & 15; return 8 * (i >> 2) + 4 * n + (i & 3); }

struct Unit { int pm, pn, seg; };
struct Prob {
    const bf16_t* A; const bf16_t* Bt; int lda, ldb, K;
    __device__ __forceinline__ const char* abase(const Unit& u) const { return (const char*)(A + (size_t)u.pm * BM * lda); }
    __device__ __forceinline__ const char* bbase(const Unit& u) const { return (const char*)(Bt + (size_t)u.pn * BM * ldb); }
    __device__ __forceinline__ int ntiles(const Unit&) const { return K / BK; }
};
struct ProbSeg {
    const bf16_t* A; const bf16_t* Bt; int lda, ldb;
    __device__ __forceinline__ int koff(int s) const { return s == 0 ? 0 : 512 + 512 * s; }
    __device__ __forceinline__ const char* abase(const Unit& u) const { return (const char*)(A + (size_t)u.pm * BM * lda + koff(u.seg)); }
    __device__ __forceinline__ const char* bbase(const Unit& u) const { return (const char*)(Bt + (size_t)u.pn * BM * ldb + koff(u.seg)); }
    __device__ __forceinline__ int ntiles(const Unit& u) const { return u.seg == 0 ? 16 : 8; }
};
struct StaticOrder {
    int nM, nN, nwg, G, c, WGM;
    __device__ __forceinline__ void init(int M, int N, int G_, int c_, int wgm = 4) { nM = M / BM; nN = N / BM; nwg = nM * nN; G = G_; c = c_; WGM = wgm; }
    __device__ __forceinline__ bool tile(long L, Unit& u) const {
        if (L >= nwg) return false;
        int wgid = (int)L; { const int q = nwg / NXCD, r = nwg % NXCD, xcd = wgid % NXCD, off = wgid / NXCD; wgid = (xcd < r ? xcd * (q + 1) : r * (q + 1) + (xcd - r) * q) + off; }
        const int nig = WGM * nN, gid = wgid / nig, fm = gid * WGM, gsz = (nM - fm) < WGM ? (nM - fm) : WGM;
        u.pm = fm + ((wgid % nig) % gsz); u.pn = (wgid % nig) / gsz; return true;
    }
    __device__ __forceinline__ bool next(int i, Unit& u) const { u.seg = 0; return tile((long)i * G + c, u); }
};
struct SegOrder : StaticOrder {
    __device__ __forceinline__ bool next(int i, Unit& u) const { u.seg = i & 3; return tile((long)(i >> 2) * G + c, u); }
};

typedef f32x4 Acc[2][2][4][2];

template <class Epi, class Sched, class P>
__device__ __forceinline__ void gemm_phase(LAS unsigned char* lds, const P g, const Sched& S, const Epi& E) {
    int tid = threadIdx.x; asm volatile("" : "+v"(tid));
    const int wid = __builtin_amdgcn_readfirstlane(tid >> 6), lane = tid & 63, wr = wid >> 2, wc = wid & 3, fr = lane & 15, fq = lane >> 4;
    unsigned voffA[2], voffB[2];
#pragma unroll
    for (int i = 0; i < 2; ++i) { int R, C; stage_rc(tid * 16 + i * 8192, R, C); const int Rb = Epi::PERM ? ((R & ~31) + perm32(R & 31)) : R;
        voffA[i] = (unsigned)(R * g.lda + C) * 2u; voffB[i] = (unsigned)(Rb * g.ldb + C) * 2u; }
    const size_t kstep = (size_t)(BK * 2);
    const size_t hstepA = (size_t)HALF * g.lda * 2, hstepB = (size_t)HALF * g.ldb * 2;
    const unsigned ldsw = (unsigned)wid * 1024u;
    const int aoff = lds_byte(wr * 64 + fr, fq * 8), boff = lds_byte(wc * 32 + fr, fq * 8);
#define PG8_SA(b, h) (((b) * 2 + (h)) * HTB)
#define PG8_SB(b, h) ((4 + (b) * 2 + (h)) * HTB)
#define PG8_STAGE(bufoff, gbase, voff) do { _Pragma("unroll") for (int _i = 0; _i < 2; ++_i) \
        __builtin_amdgcn_global_load_lds((const unsigned*)((const char*)(gbase) + (voff)[_i]), (LAS unsigned*)(lds + (bufoff) + ldsw + _i * 8192), 16, 0, 0); } while (0)
#define PG8_LDA(dst, b, h) do { _Pragma("unroll") for (int m = 0; m < 4; ++m) _Pragma("unroll") for (int k = 0; k < 2; ++k) dst[m][k] = *(const LAS bf16x8*)(lds + PG8_SA(b, h) + aoff + m * 2048 + k * 1024); } while (0)
#define PG8_LDB(dst, b, h) do { _Pragma("unroll") for (int n = 0; n < 2; ++n) _Pragma("unroll") for (int k = 0; k < 2; ++k) dst[n][k] = *(const LAS bf16x8*)(lds + PG8_SB(b, h) + boff + n * 2048 + k * 1024); } while (0)
#define PG8_MMA(ai, bj, At, Bt) do { __builtin_amdgcn_s_setprio(1); _Pragma("unroll") for (int m = 0; m < 4; ++m) _Pragma("unroll") for (int n = 0; n < 2; ++n) _Pragma("unroll") for (int k = 0; k < 2; ++k) \
        acc[ai][bj][m][n] = __builtin_amdgcn_mfma_f32_16x16x32_bf16(Bt[n][k], At[m][k], acc[ai][bj][m][n], 0, 0, 0); __builtin_amdgcn_s_setprio(0); } while (0)
#define PG8_WAIT_V(n) asm volatile("s_waitcnt vmcnt(" #n ")" ::: "memory")
#define PG8_WAIT_L(n) asm volatile("s_waitcnt lgkmcnt(" #n ")" ::: "memory")
#define PG8_BAR __builtin_amdgcn_s_barrier()
#define PG8_SCHED __builtin_amdgcn_sched_barrier(0)
    Unit cur, nxt; int ui = 0;
    if (!S.next(0, cur)) return;
    Acc acc;
#pragma unroll
    for (int a = 0; a < 2; ++a)
#pragma unroll
        for (int b = 0; b < 2; ++b)
#pragma unroll
            for (int m = 0; m < 4; ++m)
#pragma unroll
                for (int n = 0; n < 2; ++n) acc[a][b][m][n] = (f32x4){0.f, 0.f, 0.f, 0.f};
    bf16x8 At[4][2], B0[2][2], B1[2][2];
    const char* cA = g.abase(cur); const char* cB = g.bbase(cur); int nt = g.ntiles(cur);
    PG8_STAGE(PG8_SB(0, 0), cB, voffB); PG8_STAGE(PG8_SB(0, 1), cB + hstepB, voffB); PG8_STAGE(PG8_SA(0, 0), cA, voffA); PG8_STAGE(PG8_SA(0, 1), cA + hstepA, voffA);
    if (wr == 1) PG8_BAR;
    PG8_WAIT_V(2); PG8_BAR;
    PG8_STAGE(PG8_SB(1, 0), cB + kstep, voffB); PG8_STAGE(PG8_SA(1, 0), cA + kstep, voffA); PG8_STAGE(PG8_SB(1, 1), cB + hstepB + kstep, voffB);
    PG8_WAIT_V(6); PG8_BAR;
    for (;;) {
        const bool has_next = S.next(ui + 1, nxt);
        const char* nA = has_next ? g.abase(nxt) : cA; const char* nB = has_next ? g.bbase(nxt) : cB;
        for (int t = 0; t < nt; t += 2) {
            const bool last = (t == nt - 2);
            const char* a1 = cA + (size_t)(t + 1) * kstep;
            const char* a2 = last ? nA : cA + (size_t)(t + 2) * kstep; const char* b2 = last ? nB : cB + (size_t)(t + 2) * kstep;
            const char* a3 = a2 + kstep; const char* b3 = b2 + kstep;
            PG8_LDB(B0, 0, 0); PG8_LDB(B1, 0, 1); PG8_SCHED; PG8_LDA(At, 0, 0); PG8_STAGE(PG8_SA(1, 1), a1 + hstepA, voffA);
            PG8_WAIT_V(8); PG8_WAIT_L(0); PG8_BAR; PG8_MMA(0, 0, At, B0); PG8_MMA(0, 1, At, B1); PG8_BAR; PG8_SCHED;
            PG8_LDA(At, 0, 1); PG8_STAGE(PG8_SB(0, 0), b2, voffB); PG8_STAGE(PG8_SB(0, 1), b2 + hstepB, voffB); PG8_STAGE(PG8_SA(0, 0), a2, voffA);
            PG8_WAIT_V(8); PG8_WAIT_L(0); PG8_BAR; PG8_MMA(1, 0, At, B0); PG8_MMA(1, 1, At, B1); PG8_BAR; PG8_SCHED;
            PG8_LDB(B0, 1, 0); PG8_LDB(B1, 1, 1); PG8_SCHED; PG8_LDA(At, 1, 0); PG8_STAGE(PG8_SA(0, 1), a2 + hstepA, voffA);
            PG8_WAIT_V(8); PG8_WAIT_L(0); PG8_BAR; PG8_MMA(0, 0, At, B0); PG8_MMA(0, 1, At, B1); PG8_BAR; PG8_SCHED;
            PG8_LDA(At, 1, 1); PG8_STAGE(PG8_SB(1, 0), b3, voffB); PG8_STAGE(PG8_SB(1, 1), b3 + hstepB, voffB); PG8_STAGE(PG8_SA(1, 0), a3, voffA);
            PG8_WAIT_V(8); PG8_WAIT_L(0); PG8_BAR; PG8_MMA(1, 0, At, B0); PG8_MMA(1, 1, At, B1); PG8_BAR; PG8_SCHED;
        }
        if (wr == 0) PG8_BAR;
        E(acc, cur, wr, wc, fr, fq);
        if (!has_next) break;
        if (!E.keep(cur)) {
#pragma unroll
        for (int a = 0; a < 2; ++a)
#pragma unroll
            for (int b = 0; b < 2; ++b)
#pragma unroll
                for (int m = 0; m < 4; ++m)
#pragma unroll
                    for (int n = 0; n < 2; ++n) acc[a][b][m][n] = (f32x4){0.f, 0.f, 0.f, 0.f};
        }
        cur = nxt; cA = nA; cB = nB; nt = g.ntiles(cur); ++ui;
        if (wr == 1) PG8_BAR;
    }
    PG8_WAIT_V(0);
    PG8_BAR;
#undef PG8_SA
#undef PG8_SB
#undef PG8_STAGE
#undef PG8_LDA
#undef PG8_LDB
#undef PG8_MMA
#undef PG8_WAIT_V
#undef PG8_WAIT_L
#undef PG8_BAR
#undef PG8_SCHED
}

struct EpiStore {
    static constexpr bool PERM = true;
    __device__ __forceinline__ bool keep(const Unit&) const { return false; }
    bf16_t* O; int ldc;
    __device__ __forceinline__ void operator()(const Acc& acc, const Unit& u, int wr, int wc, int fr, int fq) const {
        const int row0 = u.pm * BM + wr * 64 + fr, col0 = u.pn * BM + wc * 32 + 8 * fq;
#pragma unroll
        for (int ai = 0; ai < 2; ++ai)
#pragma unroll
            for (int m = 0; m < 4; ++m) { bf16_t* rowp = O + (size_t)(row0 + ai * HALF + m * 16) * ldc + col0;
#pragma unroll
                for (int bj = 0; bj < 2; ++bj) { const f32x4 v0 = acc[ai][bj][m][0], v1 = acc[ai][bj][m][1];
                    u32x4 w; w.x = cvt_pk_bf16(v0[0], v0[1]); w.y = cvt_pk_bf16(v0[2], v0[3]); w.z = cvt_pk_bf16(v1[0], v1[1]); w.w = cvt_pk_bf16(v1[2], v1[3]);
                    *(u32x4*)(rowp + bj * HALF) = w; } }
    }
};
struct EpiZ {
    static constexpr bool PERM = true;
    __device__ __forceinline__ bool keep(const Unit&) const { return false; }
    bf16_t* Z; bf16_t* G; const float* bgate;
    __device__ __forceinline__ void operator()(const Acc& acc, const Unit& u, int wr, int wc, int fr, int fq) const {
        const int row0 = u.pm * BM + wr * 64 + fr;
        if (u.pn < 16) {
            const int col0 = u.pn * BM + wc * 32 + 8 * fq;
#pragma unroll
            for (int ai = 0; ai < 2; ++ai)
#pragma unroll
                for (int m = 0; m < 4; ++m) { bf16_t* rowp = Z + (size_t)(row0 + ai * HALF + m * 16) * 4096 + col0;
#pragma unroll
                    for (int bj = 0; bj < 2; ++bj) { const f32x4 v0 = acc[ai][bj][m][0], v1 = acc[ai][bj][m][1];
                        u32x4 w; w.x = cvt_pk_bf16(v0[0], v0[1]); w.y = cvt_pk_bf16(v0[2], v0[3]); w.z = cvt_pk_bf16(v1[0], v1[1]); w.w = cvt_pk_bf16(v1[2], v1[3]);
                        *(u32x4*)(rowp + bj * HALF) = w; } }
        } else {
            const int col0 = (u.pn - 16) * BM + wc * 32 + 8 * fq;
            f32x4 bv[2][2];
#pragma unroll
            for (int bj = 0; bj < 2; ++bj)
#pragma unroll
                for (int n = 0; n < 2; ++n) bv[bj][n] = *(const f32x4*)(bgate + col0 + bj * HALF + 4 * n) * (-1.44269504f);
            unsigned char* Gq = (unsigned char*)G + ((size_t)(u.pm * 4 + ((u.pn - 16) >> 3)) * 8 + ((u.pn - 16) & 7)) * 65536 + (size_t)(wr * 4 + wc) * 8192 + (size_t)(fq * 16 + fr) * 16;
#pragma unroll
            for (int ai = 0; ai < 2; ++ai)
#pragma unroll
                for (int m = 0; m < 4; ++m) {
                    unsigned wv[4] = {0u, 0u, 0u, 0u};
#pragma unroll
                    for (int bj = 0; bj < 2; ++bj)
#pragma unroll
                        for (int n = 0; n < 2; ++n) { const f32x4 a4 = acc[ai][bj][m][n], b4 = bv[bj][n];
#pragma unroll
                            for (int j = 0; j < 4; ++j) {
                                const float e = __builtin_amdgcn_exp2f(__builtin_fmaf(a4[j], -1.44269504f, b4[j]));
                                wv[bj * 2 + n] = __builtin_amdgcn_cvt_pk_u8_f32(fmaxf(__builtin_rintf(__builtin_amdgcn_rcpf(__builtin_fmaf(e, 1.0f / 255.0f, 1.0f / 255.0f))), 1.0f), j, wv[bj * 2 + n]); } }
                    u32x4 w; w.x = wv[0]; w.y = wv[1]; w.z = wv[2]; w.w = wv[3];
                    *(u32x4*)(Gq + (ai * 4 + m) * 1024) = w; }
        }
    }
};
struct EpiSwiglu {
    static constexpr bool PERM = true;
    __device__ __forceinline__ bool keep(const Unit&) const { return false; }
    bf16_t* O;
    __device__ __forceinline__ void operator()(const Acc& acc, const Unit& u, int wr, int wc, int fr, int fq) const {
        const int row0 = u.pm * BM + wr * 64 + fr, col0 = u.pn * HALF + wc * 32 + 8 * fq;
#pragma unroll
        for (int ai = 0; ai < 2; ++ai)
#pragma unroll
            for (int m = 0; m < 4; ++m) { bf16_t* rowp = O + (size_t)(row0 + ai * HALF + m * 16) * DFF + col0;
                f32x4 v0, v1;
#pragma unroll
                for (int j = 0; j < 4; ++j) { const float g0 = acc[ai][0][m][0][j], g1 = acc[ai][0][m][1][j];
                    v0[j] = g0 * sigmoidf_(g0) * acc[ai][1][m][0][j]; v1[j] = g1 * sigmoidf_(g1) * acc[ai][1][m][1][j]; }
                u32x4 w; w.x = cvt_pk_bf16(v0[0], v0[1]); w.y = cvt_pk_bf16(v0[2], v0[3]); w.z = cvt_pk_bf16(v1[0], v1[1]); w.w = cvt_pk_bf16(v1[2], v1[3]);
                *(u32x4*)rowp = w; }
    }
};
struct EpiResid {
    static constexpr bool PERM = true;
    __device__ __forceinline__ bool keep(const Unit&) const { return false; }
    const float* xin_ctx; const float* xin_lat; bf16_t* xb; float* yout; const float* modl; int gidx; int grow0;
    __device__ __forceinline__ void operator()(const Acc& acc, const Unit& u, int wr, int wc, int fr, int fq) const {
        const int prow = grow0 + u.pm * BM;
        const int cond = prow < TCTX ? 0 : 1 + ((prow - TCTX) >> 12);
        const float* gv = modl + (size_t)cond * 12288 + gidx * DM;
        const int rl0 = wr * 64 + fr, col0 = u.pn * BM + wc * 32 + 8 * fq;
        f32x4 g4[2][2];
#pragma unroll
        for (int bj = 0; bj < 2; ++bj)
#pragma unroll
            for (int n = 0; n < 2; ++n) g4[bj][n] = *(const f32x4*)(gv + col0 + bj * HALF + n * 4);
        bf16_t* xo = xb + (size_t)prow * DM;
        if (xin_ctx) {
            const float* xin = prow < TCTX ? xin_ctx + (size_t)prow * DM : xin_lat + (size_t)(prow - TCTX) * DM;
#pragma unroll
            for (int ai = 0; ai < 2; ++ai) {
#pragma unroll
                for (int m = 0; m < 4; ++m) { const size_t off = (size_t)(rl0 + ai * HALF + m * 16) * DM + col0;
#pragma unroll
                    for (int bj = 0; bj < 2; ++bj) { const f32x4 x0 = *(const f32x4*)(xin + off + bj * HALF), x1 = *(const f32x4*)(xin + off + bj * HALF + 4);
                        const f32x4 r0 = x0 + g4[bj][0] * acc[ai][bj][m][0], r1 = x1 + g4[bj][1] * acc[ai][bj][m][1];
                        u32x4 w; w.x = cvt_pk_bf16(r0[0], r0[1]); w.y = cvt_pk_bf16(r0[2], r0[3]); w.z = cvt_pk_bf16(r1[0], r1[1]); w.w = cvt_pk_bf16(r1[2], r1[3]);
                        *(u32x4*)(xo + off + bj * HALF) = w; } }
                asm volatile("" ::: "memory"); }
        } else {
            u32x4 xw[4][2];
#pragma unroll
            for (int m = 0; m < 4; ++m)
#pragma unroll
                for (int bj = 0; bj < 2; ++bj) xw[m][bj] = *(const u32x4*)(xo + (size_t)(rl0 + m * 16) * DM + col0 + bj * HALF);
            float* yo = yout ? yout + (size_t)prow * DM : nullptr;
#pragma unroll
            for (int ai = 0; ai < 2; ++ai) {
#pragma unroll
                for (int m = 0; m < 4; ++m) { const size_t off = (size_t)(rl0 + ai * HALF + m * 16) * DM + col0;
#pragma unroll
                    for (int bj = 0; bj < 2; ++bj) { const u32x4 w4 = xw[m][bj];
                        if (ai == 0) xw[m][bj] = *(const u32x4*)(xo + off + (size_t)HALF * DM + bj * HALF);
                        const f32x4 x0 = {bf_lo(w4.x), bf_hi(w4.x), bf_lo(w4.y), bf_hi(w4.y)}, x1 = {bf_lo(w4.z), bf_hi(w4.z), bf_lo(w4.w), bf_hi(w4.w)};
                        const f32x4 r0 = x0 + g4[bj][0] * acc[ai][bj][m][0], r1 = x1 + g4[bj][1] * acc[ai][bj][m][1];
                        if (yo) { *(f32x4*)(yo + off + bj * HALF) = r0; *(f32x4*)(yo + off + bj * HALF + 4) = r1; }
                        else { u32x4 w; w.x = cvt_pk_bf16(r0[0], r0[1]); w.y = cvt_pk_bf16(r0[2], r0[3]); w.z = cvt_pk_bf16(r1[0], r1[1]); w.w = cvt_pk_bf16(r1[2], r1[3]);
                            *(u32x4*)(xo + off + bj * HALF) = w; } } } }
        }
    }
};
struct EpiMerge {
    static constexpr bool PERM = true;
    const unsigned char* G; bf16_t* Mo;
    __device__ __forceinline__ bool keep(const Unit& u) const { return u.seg != 3; }
    __device__ __forceinline__ void operator()(Acc& acc, const Unit& u, int wr, int wc, int fr, int fq) const {
        const int seg = u.seg;
        const int urow = u.pm * BM + wr * 64, ucol = u.pn * BM + wc * 32;
        const char* gbase = (const char*)(G + ((size_t)(u.pm * 4 + seg) * 8 + u.pn) * 65536 + (size_t)(wr * 4 + wc) * 8192);
        char* mbase = (char*)(Mo + (size_t)urow * DM + ucol);
        unsigned goff = (unsigned)(fq * 16 + fr) * 16u, moff = (unsigned)(fr * DM + 8 * fq) * 2u;
        asm volatile("" : "+v"(goff), "+v"(moff));
        u32x4 gw[8], hw[8];
#pragma unroll
        for (int q = 0; q < 8; ++q) { gw[q] = *(const u32x4*)(gbase + q * 1024 + goff);
            if (seg != 3) hw[q] = *(const u32x4*)(gbase + 8 * 65536 + q * 1024 + goff); else hw[q] = (u32x4){0u, 0u, 0u, 0u}; }
#pragma unroll
        for (int ai = 0; ai < 2; ++ai) {
#pragma unroll
            for (int m = 0; m < 4; ++m) {
                const u32x4 g4 = gw[ai * 4 + m], h4 = hw[ai * 4 + m];
                const unsigned gq[4] = {g4.x, g4.y, g4.z, g4.w}, hq[4] = {h4.x, h4.y, h4.z, h4.w};
#pragma unroll
                for (int bj = 0; bj < 2; ++bj) {
                    float f[8];
#pragma unroll
                    for (int n = 0; n < 2; ++n) { const unsigned gx = gq[bj * 2 + n], hx = hq[bj * 2 + n];
                        f[4 * n + 0] = (float)(gx & 255u); f[4 * n + 1] = (float)((gx >> 8) & 255u); f[4 * n + 2] = (float)((gx >> 16) & 255u); f[4 * n + 3] = (float)(gx >> 24);
                        if (seg != 3) { f[4 * n + 0] *= __builtin_amdgcn_rcpf((float)(hx & 255u)); f[4 * n + 1] *= __builtin_amdgcn_rcpf((float)((hx >> 8) & 255u));
                            f[4 * n + 2] *= __builtin_amdgcn_rcpf((float)((hx >> 16) & 255u)); f[4 * n + 3] *= __builtin_amdgcn_rcpf((float)(hx >> 24)); }
                        else { f[4 * n + 0] *= (1.0f / 255.0f); f[4 * n + 1] *= (1.0f / 255.0f); f[4 * n + 2] *= (1.0f / 255.0f); f[4 * n + 3] *= (1.0f / 255.0f); } }
                    f32x4 v0 = acc[ai][bj][m][0], v1 = acc[ai][bj][m][1];
                    v0[0] *= f[0]; v0[1] *= f[1]; v0[2] *= f[2]; v0[3] *= f[3]; v1[0] *= f[4]; v1[1] *= f[5]; v1[2] *= f[6]; v1[3] *= f[7];
                    if (seg != 3) { acc[ai][bj][m][0] = v0; acc[ai][bj][m][1] = v1; }
                    else { u32x4 w; w.x = cvt_pk_bf16(v0[0], v0[1]); w.y = cvt_pk_bf16(v0[2], v0[3]); w.z = cvt_pk_bf16(v1[0], v1[1]); w.w = cvt_pk_bf16(v1[2], v1[3]);
                        *(u32x4*)(mbase + (size_t)(ai * HALF + m * 16) * (DM * 2) + bj * 256 + moff) = w; } } }
            asm volatile("" ::: "memory"); }
    }
};
}

struct Args { const float* in[31]; float* out; unsigned char* ws; int step_lo, step_hi; };
enum { I_XP = 0, I_XS, I_CCKV, I_CKPE, I_C, I_CCTX, I_WMOD, I_BMOD, I_NMIX, I_NFFN, I_WIN, I_BGATE, I_QAN, I_KVAN, I_WUQ, I_WUKV, I_QN, I_KN,
       I_WPOOL, I_PSCALE, I_SGUN, I_WSP, I_BSP, I_CONVW, I_WBA, I_WBP, I_WBS, I_WBC, I_WOUT, I_WFI, I_WFO };

struct Grp { int row0, rows, nseq, L, C, tkv; };
__device__ __forceinline__ Grp grp_of(int g) {
    Grp r;
    if (g == 0) { r.row0 = 0; r.rows = 4096; r.nseq = 16; r.L = 256; r.C = 0; r.tkv = 4096; }
    else { r.row0 = TCTX + (g - 1) * 16384; r.rows = 16384; r.nseq = 4; r.L = 4096; r.C = 256; r.tkv = 17408; }
    return r;
}

struct Frame {
    LAS unsigned char* lds;
    int tid, lane, wave, bx, G, gw, ngw;
    const float* const* in; float* out; unsigned char* ws;
};

__device__ __forceinline__ Frame fresh(const Frame& F0) {
    Frame F = F0;
    asm volatile("" : "+v"(F.tid));
    int z; asm volatile("s_mov_b32 %0, 0" : "=s"(z));
    F.in = F0.in + z; F.out = F0.out + z; F.ws = F0.ws + z; F.bx = F0.bx + z;
    F.lane = F.tid & 63; F.wave = __builtin_amdgcn_readfirstlane(F.tid >> 6);
    F.gw = F.bx * NWAVE + F.wave; F.ngw = F.G * NWAVE;
    return F;
}
#define LAUNDER_S(x) do { int z_; asm volatile("s_mov_b32 %0, 0" : "=s"(z_)); (x) += z_; } while (0)
struct TrDesc { const float* W; const float* ks; bf16_t* dst; int ldw, k0, n0, ldd; };
__device__ __forceinline__ void tr_load(const TrDesc& d, f32x4 (&tv)[8], int lane) {
#pragma unroll
    for (int i = 0; i < 8; ++i) tv[i] = *(const f32x4*)(d.W + (size_t)(d.k0 + 8 * i + (lane >> 3)) * d.ldw + d.n0 + 4 * (lane & 7));
}
__device__ __forceinline__ void tr_finish(const TrDesc& d, const f32x4 (&tv)[8], LAS float* scr, int lane) {
#pragma unroll
    for (int i = 0; i < 8; ++i) { const int kk = 8 * i + (lane >> 3); f32x4 v = tv[i]; if (d.ks) v = v * d.ks[d.k0 + kk];
        LAS float* q = scr + kk * 33 + 4 * (lane & 7); q[0] = v[0]; q[1] = v[1]; q[2] = v[2]; q[3] = v[3]; }
    LDS_WAIT(); asm volatile("" ::: "memory");
    const int c = lane & 7;
#pragma unroll
    for (int j = 0; j < 4; ++j) { const int n = (lane >> 3) + 8 * j; const LAS float* s = scr + (8 * c) * 33 + n;
        u32x4 o; o.x = cvt_pk_bf16(s[0 * 33], s[1 * 33]); o.y = cvt_pk_bf16(s[2 * 33], s[3 * 33]); o.z = cvt_pk_bf16(s[4 * 33], s[5 * 33]); o.w = cvt_pk_bf16(s[6 * 33], s[7 * 33]);
        *(u32x4*)(d.dst + (size_t)n * d.ldd + d.k0 + 8 * c) = o; }
    LDS_WAIT(); asm volatile("" ::: "memory");
}
__device__ __forceinline__ TrDesc tr_desc(int r, int l, const float* const* in, unsigned char* wl) {
    constexpr int IA = 32 * 385, IB = 12 * 48, IC = 4 * 64, ID = 16 * 64, IE = 8 * 64, IF_ = 8 * 64, IG = 32 * 64, IH = 32 * 352;
    TrDesc d; d.ks = nullptr;
    if (r < IA) { const int kb = r / 385, sg = r % 385; d.W = in[I_WIN] + (size_t)l * DM * NINW; d.ldw = NINW; d.k0 = 64 * kb; d.n0 = 32 * sg; d.ldd = 2048;
        d.dst = sg < 32 ? (bf16_t*)(wl + OFF_WIN) + (size_t)(32 * sg) * 2048 : sg == 32 ? (bf16_t*)(wl + OFF_WKPE) : (bf16_t*)(wl + OFF_WIN) + (size_t)(32 * (sg - 1)) * 2048; return d; } r -= IA;
    if (r < IB) { const int kb = r / 48, sg = r % 48; d.W = in[I_WUQ] + (size_t)l * QLORA * 1536; d.ldw = 1536; d.k0 = 64 * kb; d.n0 = 32 * sg; d.ldd = 768; d.ks = in[I_QAN] + l * QLORA;
        d.dst = (bf16_t*)(wl + OFF_WUQ) + (size_t)(32 * sg) * 768; return d; } r -= IB;
    if (r < IC) { const int kb = r / 64, sg = r % 64, hh = sg >> 2, part = sg & 3; d.W = in[I_WUKV] + (size_t)l * KVL * 2048; d.ldw = 2048; d.k0 = 64 * kb; d.n0 = 32 * sg; d.ldd = 256;
        d.dst = part < 2 ? (bf16_t*)(wl + OFF_WUK) + (size_t)(hh * 64 + 32 * part) * 256 : (bf16_t*)(wl + OFF_WUV) + (size_t)(hh * 64 + 32 * (part - 2)) * 256; return d; } r -= IC;
    if (r < ID) { const int kb = r / 64, sg = r % 64; d.W = in[I_WBA] + (size_t)l * 1024 * DM; d.ldw = DM; d.k0 = 64 * kb; d.n0 = 32 * sg; d.ldd = 2560; d.dst = (bf16_t*)(wl + OFF_WBR) + (size_t)(32 * sg) * 2560; return d; } r -= ID;
    if (r < IE) { const int kb = r / 64, sg = r % 64; d.W = in[I_WBS] + (size_t)l * 512 * DM; d.ldw = DM; d.k0 = 64 * kb; d.n0 = 32 * sg; d.ldd = 2560; d.dst = (bf16_t*)(wl + OFF_WBR) + (size_t)(32 * sg) * 2560 + 1536; return d; } r -= IE;
    if (r < IF_) { const int kb = r / 64, sg = r % 64; d.W = in[I_WBC] + (size_t)l * 512 * DM; d.ldw = DM; d.k0 = 64 * kb; d.n0 = 32 * sg; d.ldd = 2560; d.dst = (bf16_t*)(wl + OFF_WBR) + (size_t)(32 * sg) * 2560 + 2048; return d; } r -= IF_;
    if (r < IG) { const int kb = r / 64, sg = r % 64; d.W = in[I_WOUT] + (size_t)l * DM * DM; d.ldw = DM; d.k0 = 64 * kb; d.n0 = 32 * sg; d.ldd = 2048; d.dst = (bf16_t*)(wl + OFF_WOUT) + (size_t)(32 * sg) * 2048; return d; } r -= IG;
    if (r < IH) { const int kb = r / 352, sg = r % 352; const int s2 = sg < 176 ? sg : sg - 176; const int drow = 256 * (s2 >> 2) + 32 * (s2 & 3) + (sg < 176 ? 0 : 128);
        d.W = in[I_WFI] + (size_t)l * DM * 2 * DFF; d.ldw = 2 * DFF; d.k0 = 64 * kb; d.n0 = 32 * sg; d.ldd = 2048; d.dst = (bf16_t*)(wl + OFF_WFI) + (size_t)drow * 2048; return d; } r -= IH;
    { const int kb = r / 64, sg = r % 64; d.W = in[I_WFO] + (size_t)l * DFF * DM; d.ldw = DM; d.k0 = 64 * kb; d.n0 = 32 * sg; d.ldd = DFF; d.dst = (bf16_t*)(wl + OFF_WFO) + (size_t)(32 * sg) * DFF; return d; }
}
__device__ __forceinline__ void p0_prologue(Frame& F, int lcv) {
    if (lcv == 0)
    {
        LAS float* sc = (LAS float*)F.lds;
        LAS float* red = (LAS float*)(F.lds + 81920);
        for (int idx = F.tid; idx < NCOND * DM; idx += NTHR) { const int ci = idx >> 11, k = idx & 2047;
            const float v = ci == 0 ? F.in[I_CCTX][k] : F.in[I_C][(ci - 1) * DM + k];
            sc[k * 10 + ci] = v * sigmoidf_(v); }
        __syncthreads();
        for (int it = F.bx; it < NLAYER * 96; it += F.G) {
            const int l = it / 96, jb = it % 96, col = jb * 128 + 2 * F.lane;
            const float* wp = F.in[I_WMOD] + (size_t)l * DM * 12288 + col;
            float a[9][2];
#pragma unroll
            for (int i = 0; i < 9; ++i) { a[i][0] = 0.f; a[i][1] = 0.f; }
            const int kb = F.wave * 256;
#pragma unroll 16
            for (int k = kb; k < kb + 256; ++k) { const f32x2 wv = *(const f32x2*)(wp + (size_t)k * 12288);
                const LAS f32x2* s2 = (const LAS f32x2*)(sc + k * 10);
                const f32x2 s0 = s2[0], s1 = s2[1], s2_ = s2[2], s3 = s2[3], s4 = s2[4];
                a[0][0] += wv.x * s0.x; a[0][1] += wv.y * s0.x; a[1][0] += wv.x * s0.y; a[1][1] += wv.y * s0.y;
                a[2][0] += wv.x * s1.x; a[2][1] += wv.y * s1.x; a[3][0] += wv.x * s1.y; a[3][1] += wv.y * s1.y;
                a[4][0] += wv.x * s2_.x; a[4][1] += wv.y * s2_.x; a[5][0] += wv.x * s2_.y; a[5][1] += wv.y * s2_.y;
                a[6][0] += wv.x * s3.x; a[6][1] += wv.y * s3.x; a[7][0] += wv.x * s3.y; a[7][1] += wv.y * s3.y;
                a[8][0] += wv.x * s4.x; a[8][1] += wv.y * s4.x; }
#pragma unroll
            for (int i = 0; i < 9; ++i) *(LAS f32x2*)(red + (F.wave * 9 + i) * 128 + 2 * F.lane) = (f32x2){a[i][0], a[i][1]};
            __syncthreads();
            for (int o = F.tid; o < 1152; o += NTHR) { const int i = o >> 7, ln = o & 127; float s = 0.f;
#pragma unroll
                for (int w = 0; w < 8; ++w) s += red[(w * 9 + i) * 128 + ln];
                const int c2 = jb * 128 + ln;
                ((float*)(F.ws + WS_MOD))[((size_t)l * NCOND + i) * 12288 + c2] = s + F.in[I_BMOD][(size_t)l * 12288 + c2]; }
            __syncthreads();
        }
    }
    __syncthreads();
    {
        LAS float* scr = (LAS float*)(F.lds + F.wave * 16384);
        constexpr int NIT = 32 * 385 + 12 * 48 + 4 * 64 + 16 * 64 + 8 * 64 + 8 * 64 + 32 * 64 + 32 * 352 + 88 * 64;
        unsigned char* wl = F.ws + WS_W0;
        int it = F.gw;
        TrDesc cur; f32x4 tv[8];
        if (it < NIT) { cur = tr_desc(it, lcv, F.in, wl); tr_load(cur, tv, F.lane); }
        for (; it < NIT; it += F.ngw) {
            TrDesc nxt = cur; f32x4 tn[8];
            const bool hn = it + F.ngw < NIT;
            if (hn) { nxt = tr_desc(it + F.ngw, lcv, F.in, wl); tr_load(nxt, tn, F.lane); }
            tr_finish(cur, tv, scr, F.lane);
            if (hn) {
#pragma unroll
                for (int i = 0; i < 8; ++i) tv[i] = tn[i];
                cur = nxt; }
        }
    }
    {
        int ngt = F.G * NTHR; LAUNDER_S(ngt);
        const int gt = F.bx * NTHR + F.tid;
        for (int e = gt; e < 65536; e += ngt) { const int l = lcv;
            ((bf16_t*)(F.ws + WS_W0 + OFF_WSP))[e] = (bf16_t)(cvt_pk_bf16(F.in[I_WSP][l * 65536 + e], 0.f) & 0xffffu); }
    }
    {
        LAS float* Al = (LAS float*)F.lds;
        LAS float* Bl = (LAS float*)(F.lds + 65536);
        for (int it = F.bx; it < 4 * 32; it += F.G) {
            const int l = lcv, g = (it >> 5) & 3, nb = it & 31;
            const float* wp = F.in[I_WPOOL] + (size_t)(l * 4 + g) * 128 * 128;
            const float* ps = F.in[I_PSCALE] + l * 512 + g * 128;
            const float* wb = F.in[I_WBP] + ((size_t)l * 512 + g * 128) * DM + nb * 64;
            __syncthreads();
#pragma unroll
            for (int q = 0; q < 8; ++q) { const int i4 = F.tid + NTHR * q, k = i4 >> 5, j4 = (i4 & 31) * 4;
                *(LAS f32x4*)(Al + k * 128 + j4) = *(const f32x4*)(wp + k * 128 + j4) * *(const f32x4*)(ps + j4); }
#pragma unroll
            for (int q = 0; q < 4; ++q) { const int i4 = F.tid + NTHR * q, j = i4 >> 4, n4 = (i4 & 15) * 4;
                *(LAS f32x4*)(Bl + j * 64 + n4) = *(const f32x4*)(wb + (size_t)j * DM + n4); }
            __syncthreads();
            const int n = F.tid & 63, k0 = (F.tid >> 6) * 16;
            float acc[16];
#pragma unroll
            for (int kk = 0; kk < 16; ++kk) acc[kk] = 0.f;
            for (int j4 = 0; j4 < 32; ++j4) {
                const float b0 = Bl[(4 * j4 + 0) * 64 + n], b1 = Bl[(4 * j4 + 1) * 64 + n], b2 = Bl[(4 * j4 + 2) * 64 + n], b3 = Bl[(4 * j4 + 3) * 64 + n];
#pragma unroll
                for (int kk = 0; kk < 16; ++kk) { const f32x4 a4 = *(const LAS f32x4*)(Al + (k0 + kk) * 128 + 4 * j4); acc[kk] += (a4[0] * b0 + a4[1] * b1) + (a4[2] * b2 + a4[3] * b3); } }
            bf16_t* dst = (bf16_t*)(F.ws + WS_W0 + OFF_WBR) + (size_t)(nb * 64 + n) * 2560 + 1024 + g * 128 + k0;
            float o0[8], o1[8];
#pragma unroll
            for (int kk = 0; kk < 8; ++kk) { o0[kk] = acc[kk]; o1[kk] = acc[8 + kk]; }
            store8(dst, o0); store8(dst + 8, o1);
        }
        __syncthreads();
    }
}

template <bool KPE, bool XBF>
__device__ __forceinline__ void thin_norm(Frame& F, int l, const float* xc, const float* xl, const float* nw, int ish, int isc) {
    constexpr int HL = 4112;
    LAS unsigned char* hl = F.lds; LAS float* red = (LAS float*)(F.lds + 66048);
    const float* modl = (const float*)(F.ws + WS_MOD) + (size_t)l * NCOND * 12288;
    bf16_t* H = (bf16_t*)(F.ws + WS_H);
    const bf16_t* XB = (const bf16_t*)(F.ws + WS_XB);
    const bf16_t* WK = (const bf16_t*)(F.ws + WS_W0 + OFF_WKPE);
    bf16_t* KP = (bf16_t*)(F.ws + WS_KPE);
    const int nitems = TALL / 16, per = (nitems + F.G - 1) / F.G, it_lo = F.bx * per, it_hi = (it_lo + per < nitems) ? it_lo + per : nitems;
    f32x4 A[8], B[8]; int cond_cur = -1;
    f32x4 vn[8]; u32x4 vb[4];
#define TN_LOAD(row_) do { if (XBF) { const bf16_t* xr_ = XB + (size_t)(row_) * DM + 8 * F.lane; \
            _Pragma("unroll") for (int j = 0; j < 4; ++j) vb[j] = *(const u32x4*)(xr_ + 512 * j); } \
        else { const float* xr_ = ((row_) < TCTX ? xc + (size_t)(row_) * DM : xl + (size_t)((row_) - TCTX) * DM) + 8 * F.lane; \
            _Pragma("unroll") for (int j = 0; j < 4; ++j) { vn[2 * j] = *(const f32x4*)(xr_ + 512 * j); vn[2 * j + 1] = *(const f32x4*)(xr_ + 512 * j + 4); } } } while (0)
    if (it_lo < it_hi) TN_LOAD(it_lo * 16 + 2 * F.wave);
    for (int it = it_lo; it < it_hi; ++it) {
        const int prow = it * 16;
        const int cond = prow < TCTX ? 0 : 1 + ((prow - TCTX) >> 12);
        if (cond != cond_cur) { cond_cur = cond;
            const float* sh = modl + (size_t)cond * 12288 + ish * DM; const float* sc = modl + (size_t)cond * 12288 + isc * DM;
#pragma unroll
            for (int j = 0; j < 8; ++j) { const int c = 8 * F.lane + 512 * (j >> 1) + 4 * (j & 1); const f32x4 w4 = *(const f32x4*)(nw + c), s4 = *(const f32x4*)(sc + c); A[j] = w4 * (1.0f + s4); B[j] = *(const f32x4*)(sh + c); } }
#pragma unroll
        for (int rr = 0; rr < 2; ++rr) {
            const int rl = 2 * F.wave + rr, row = prow + rl; float ss = 0.f;
            f32x4 v[8];
            if (XBF) {
#pragma unroll
                for (int j = 0; j < 4; ++j) { const u32x4 w = vb[j]; v[2 * j] = (f32x4){bf_lo(w.x), bf_hi(w.x), bf_lo(w.y), bf_hi(w.y)}; v[2 * j + 1] = (f32x4){bf_lo(w.z), bf_hi(w.z), bf_lo(w.w), bf_hi(w.w)}; }
            } else {
#pragma unroll
                for (int j = 0; j < 8; ++j) v[j] = vn[j];
            }
            if (rr == 0) TN_LOAD(row + 1); else if (it + 1 < it_hi) TN_LOAD(row + 15);
#pragma unroll
            for (int j = 0; j < 8; ++j) ss += (v[j][0] * v[j][0] + v[j][1] * v[j][1]) + (v[j][2] * v[j][2] + v[j][3] * v[j][3]);
            const float rstd = rsqrtf(wave_sum(ss) * (1.0f / DM) + EPS);
#pragma unroll
            for (int j = 0; j < 4; ++j) { const f32x4 h0 = v[2 * j] * rstd * A[2 * j] + B[2 * j], h1 = v[2 * j + 1] * rstd * A[2 * j + 1] + B[2 * j + 1];
                u32x4 w; w.x = cvt_pk_bf16(h0[0], h0[1]); w.y = cvt_pk_bf16(h0[2], h0[3]); w.z = cvt_pk_bf16(h1[0], h1[1]); w.w = cvt_pk_bf16(h1[2], h1[3]);
                *(u32x4*)(H + (size_t)row * DM + 8 * F.lane + 512 * j) = w;
                if (KPE) *(LAS u32x4*)(hl + rl * HL + (8 * F.lane + 512 * j) * 2) = w; }
        }
        if (KPE) {
            __syncthreads();
            const int fr = F.lane & 15, fq = F.lane >> 4;
            f32x4 a0 = {0.f, 0.f, 0.f, 0.f}, a1 = {0.f, 0.f, 0.f, 0.f};
#pragma unroll
            for (int ks = 0; ks < 8; ++ks) { const int k = 256 * F.wave + 32 * ks + 8 * fq;
                const bf16x8 af = *(const LAS bf16x8*)(hl + fr * HL + k * 2);
                const bf16x8 b0 = *(const bf16x8*)(WK + (size_t)fr * DM + k), b1 = *(const bf16x8*)(WK + (size_t)(16 + fr) * DM + k);
                a0 = __builtin_amdgcn_mfma_f32_16x16x32_bf16(b0, af, a0, 0, 0, 0); a1 = __builtin_amdgcn_mfma_f32_16x16x32_bf16(b1, af, a1, 0, 0, 0); }
            *(LAS f32x4*)(red + F.wave * 512 + fr * 32 + 4 * fq) = a0; *(LAS f32x4*)(red + F.wave * 512 + fr * 32 + 16 + 4 * fq) = a1;
            __syncthreads();
            { const int rl = F.tid >> 5, n = F.tid & 31; float s = 0.f;
#pragma unroll
                for (int w = 0; w < 8; ++w) s += red[w * 512 + rl * 32 + n];
                const int row = prow + rl;
                KP[(size_t)row * 32 + n] = (bf16_t)(cvt_pk_bf16(s, 0.f) & 0xffffu);
                if (row < TCTX) { const int b = row >> 8, sidx = row & 255; F.out[(size_t)TALL * DM + (size_t)16 * 2 * 256 * 256 + ((size_t)(b * 2 + l) * 256 + sidx) * 32 + n] = s; } }
            __syncthreads();
        }
    }
#undef TN_LOAD
}

__device__ __forceinline__ void thin_b(Frame& F, int l, int g) {
    const Grp gr = grp_of(g);
    unsigned char* gb = F.ws + WS_G;
    const bf16_t* Z = (const bf16_t*)(gb + G_Z); bf16_t* CKV = (bf16_t*)(gb + G_CKV); bf16_t* BR = (bf16_t*)(gb + G_BR);
    const float* kvan = F.in[I_KVAN] + l * KVL; const float* convw = F.in[I_CONVW] + l * 3 * 512;
    const int lane = F.lane;
    for (int r = gr.rows + F.gw; r < gr.tkv; r += F.ngw) {
        const int ci = r - gr.rows, sq = ci >> 8, p = ci & 255, b = 4 * (g - 1) + sq;
        const f32x4 v = *(const f32x4*)(F.in[I_CCKV] + (((size_t)b * 2 + l) * 256 + p) * 256 + 4 * lane);
        u32x2 w; w.x = cvt_pk_bf16(v[0], v[1]); w.y = cvt_pk_bf16(v[2], v[3]); *(u32x2*)(CKV + (size_t)r * 256 + 4 * lane) = w;
    }
    for (int ch = F.gw; ch < (gr.rows >> 2); ch += F.ngw) {
        const int r0 = ch * 4, pos0 = r0 % gr.L;
        const bf16_t* z0 = Z + (size_t)r0 * 4096;
        const int c0 = 8 * lane;
        u32x2 cw[4];
#pragma unroll
        for (int i = 0; i < 4; ++i) cw[i] = *(const u32x2*)(z0 + (size_t)i * 4096 + 768 + 4 * lane);
        u32x4 bgw[4], cgw[6], xcw[6];
#pragma unroll
        for (int i = 0; i < 4; ++i) bgw[i] = *(const u32x4*)(z0 + (size_t)i * 4096 + 2560 + c0);
#pragma unroll
        for (int j = 0; j < 6; ++j) { const int pr = pos0 - 1 + j; const bool ok = pr >= 0 && pr < gr.L;
            cgw[j] = ok ? *(const u32x4*)(z0 + (ptrdiff_t)(j - 1) * 4096 + 3072 + c0) : (u32x4){0u, 0u, 0u, 0u};
            xcw[j] = ok ? *(const u32x4*)(z0 + (ptrdiff_t)(j - 1) * 4096 + 3584 + c0) : (u32x4){0u, 0u, 0u, 0u}; }
        const int wh = 1 << (lane >> 4);
        u32x4 pw_[19];
#pragma unroll
        for (int j = 0; j < 19; ++j) { const int d = j - 8, pr = pos0 + d; const bool ok = pr >= 0 && pr < gr.L && d >= -wh && d <= wh + 2;
            pw_[j] = ok ? *(const u32x4*)(z0 + (ptrdiff_t)d * 4096 + 1024 + c0) : (u32x4){0u, 0u, 0u, 0u}; }
        { const f32x4 kw4 = *(const f32x4*)(kvan + 4 * lane);
#pragma unroll
          for (int i = 0; i < 4; ++i) { f32x4 v = {bf_lo(cw[i].x), bf_hi(cw[i].x), bf_lo(cw[i].y), bf_hi(cw[i].y)};
            const float ss = wave_sum((v[0] * v[0] + v[1] * v[1]) + (v[2] * v[2] + v[3] * v[3]));
            v = v * rsqrtf(ss * (1.0f / KVL) + EPS) * kw4;
            u32x2 o; o.x = cvt_pk_bf16(v[0], v[1]); o.y = cvt_pk_bf16(v[2], v[3]); *(u32x2*)(CKV + (size_t)(r0 + i) * 256 + 4 * lane) = o;
            if (g == 0) { const int rr = r0 + i, b = rr >> 8, sidx = rr & 255; *(f32x4*)(F.out + (size_t)TALL * DM + ((size_t)(b * 2 + l) * 256 + sidx) * 256 + 4 * lane) = v; } } }
        { float y[6][8];
#pragma unroll
          for (int j = 0; j < 6; ++j) { y[j][0] = bf_lo(cgw[j].x) * bf_lo(xcw[j].x); y[j][1] = bf_hi(cgw[j].x) * bf_hi(xcw[j].x); y[j][2] = bf_lo(cgw[j].y) * bf_lo(xcw[j].y); y[j][3] = bf_hi(cgw[j].y) * bf_hi(xcw[j].y);
              y[j][4] = bf_lo(cgw[j].z) * bf_lo(xcw[j].z); y[j][5] = bf_hi(cgw[j].z) * bf_hi(xcw[j].z); y[j][6] = bf_lo(cgw[j].w) * bf_lo(xcw[j].w); y[j][7] = bf_hi(cgw[j].w) * bf_hi(xcw[j].w); }
          float k0[8], k1[8], k2[8];
#pragma unroll
          for (int q = 0; q < 8; ++q) { k0[q] = convw[c0 + q]; k1[q] = convw[512 + c0 + q]; k2[q] = convw[1024 + c0 + q]; }
#pragma unroll
          for (int i = 0; i < 4; ++i) { const float bgv[8] = {bf_lo(bgw[i].x), bf_hi(bgw[i].x), bf_lo(bgw[i].y), bf_hi(bgw[i].y), bf_lo(bgw[i].z), bf_hi(bgw[i].z), bf_lo(bgw[i].w), bf_hi(bgw[i].w)};
              float o[8];
#pragma unroll
              for (int q = 0; q < 8; ++q) o[q] = bgv[q] * (k0[q] * y[i][q] + k1[q] * y[i + 1][q] + k2[q] * y[i + 2][q]);
              store8(BR + (size_t)(r0 + i) * 2560 + 2048 + c0, o); } }
        { float s[4][8], cnt[4];
#pragma unroll
          for (int i = 0; i < 4; ++i) { cnt[i] = 0.f;
#pragma unroll
              for (int q = 0; q < 8; ++q) s[i][q] = 0.f; }
#pragma unroll
          for (int j = 0; j < 19; ++j) { const int d = j - 8, pr = pos0 + d; const bool inseq = pr >= 0 && pr < gr.L;
              const float x[8] = {bf_lo(pw_[j].x), bf_hi(pw_[j].x), bf_lo(pw_[j].y), bf_hi(pw_[j].y), bf_lo(pw_[j].z), bf_hi(pw_[j].z), bf_lo(pw_[j].w), bf_hi(pw_[j].w)};
#pragma unroll
              for (int i = 0; i < 4; ++i) { if (d - i < -8 || d - i > 7) continue;
                  const float mk = (inseq && d - i >= -wh && d - i <= wh - 1) ? 1.0f : 0.0f; cnt[i] += mk;
#pragma unroll
                  for (int q = 0; q < 8; ++q) s[i][q] += mk * x[q]; } }
#pragma unroll
          for (int i = 0; i < 4; ++i) { const float inv = 1.0f / cnt[i]; const u32x4 w = pw_[8 + i];
              const float x[8] = {bf_lo(w.x), bf_hi(w.x), bf_lo(w.y), bf_hi(w.y), bf_lo(w.z), bf_hi(w.z), bf_lo(w.w), bf_hi(w.w)};
              float o[8];
#pragma unroll
              for (int q = 0; q < 8; ++q) o[q] = s[i][q] * inv - x[q];
              store8(BR + (size_t)(r0 + i) * 2560 + 1024 + c0, o); } }
    }
    {
        constexpr int VS = 272;
        LAS unsigned char* vt = F.lds;
        const bf16_t* WSP = (const bf16_t*)(F.ws + WS_W0 + OFF_WSP);
        const float* sgn = F.in[I_SGUN] + l * 512; const float* bsp = F.in[I_BSP] + l * 512;
        const int nun = (gr.rows >> 7) * 4;
        const int fr = lane & 15, fq = lane >> 4, wq = F.wave >> 1, wcn = F.wave & 1;
        u32x4 wv[16];
        if (F.bx < nun) { const int r0 = (F.bx >> 2) * 128;
#pragma unroll
            for (int pp = 0; pp < 16; ++pp) wv[pp] = *(const u32x4*)(Z + (size_t)(r0 + 16 * F.wave + pp) * 4096 + 2048 + 8 * lane); }
        for (int un = F.bx; un < nun; un += F.G) {
            const int ch = un >> 2, gq = un & 3, r0 = ch * 128;
            bf16x8 af[4][2]; u32x2 uw[2][4];
#pragma unroll
            for (int ks = 0; ks < 4; ++ks)
#pragma unroll
                for (int m = 0; m < 2; ++m) af[ks][m] = *(const bf16x8*)(WSP + ((size_t)gq * 128 + 32 * wq + 16 * m + fr) * 128 + 32 * ks + 8 * fq);
#pragma unroll
            for (int m = 0; m < 2; ++m)
#pragma unroll
                for (int n = 0; n < 4; ++n) uw[m][n] = *(const u32x2*)(Z + (size_t)(r0 + 32 * wq + 16 * m + fr) * 4096 + 1536 + gq * 128 + 64 * wcn + 16 * n + 4 * fq);
            const int cl = 8 * (lane & 15);
            const f32x4 n0 = *(const f32x4*)(sgn + gq * 128 + cl), n1 = *(const f32x4*)(sgn + gq * 128 + cl + 4);
            const float bq0 = bsp[gq * 128 + 32 * wq + fr], bq1 = bsp[gq * 128 + 32 * wq + 16 + fr];
            __syncthreads();
#pragma unroll
            for (int g4 = 0; g4 < 4; ++g4) {
                float nv[4][8];
#pragma unroll
                for (int q4 = 0; q4 < 4; ++q4) { const u32x4 w = wv[4 * g4 + q4];
                    float v[8] = {bf_lo(w.x), bf_hi(w.x), bf_lo(w.y), bf_hi(w.y), bf_lo(w.z), bf_hi(w.z), bf_lo(w.w), bf_hi(w.w)};
                    float ss = 0.f;
#pragma unroll
                    for (int j = 0; j < 8; ++j) { v[j] = gelu_tanh(v[j]); ss += v[j] * v[j]; }
                    const float rstd = rsqrtf(wave_sum(ss) * (1.0f / 512.0f) + EPS);
#pragma unroll
                    for (int j = 0; j < 8; ++j) nv[q4][j] = v[j] * rstd * (j < 4 ? n0[j & 3] : n1[j & 3]); }
                if ((lane >> 4) == gq) { const int p0 = 16 * F.wave + 4 * g4;
                    LAS unsigned char* dst = vt + cl * VS + ((((p0 >> 3) ^ (lane & 7)) << 4) | ((p0 & 4) << 1));
#pragma unroll
                    for (int j = 0; j < 8; ++j) *(LAS u32x2*)(dst + j * VS) = (u32x2){cvt_pk_bf16(nv[0][j], nv[1][j]), cvt_pk_bf16(nv[2][j], nv[3][j])}; }
            }
            if (un + F.G < nun) { const int r1 = ((un + F.G) >> 2) * 128;
#pragma unroll
                for (int pp = 0; pp < 16; ++pp) wv[pp] = *(const u32x4*)(Z + (size_t)(r1 + 16 * F.wave + pp) * 4096 + 2048 + 8 * lane); }
            __syncthreads();
            f32x4 acc[2][4];
#pragma unroll
            for (int m = 0; m < 2; ++m)
#pragma unroll
                for (int n = 0; n < 4; ++n) acc[m][n] = (f32x4){0.f, 0.f, 0.f, 0.f};
#pragma unroll
            for (int ks = 0; ks < 4; ++ks) {
                bf16x8 bfr[4];
#pragma unroll
                for (int n = 0; n < 4; ++n) bfr[n] = *(const LAS bf16x8*)(vt + (64 * wcn + 16 * n + fr) * VS + (((4 * ks + fq) ^ ((2 * n + (fr >> 3)) & 7)) << 4));
#pragma unroll
                for (int m = 0; m < 2; ++m)
#pragma unroll
                    for (int n = 0; n < 4; ++n) acc[m][n] = __builtin_amdgcn_mfma_f32_16x16x32_bf16(bfr[n], af[ks][m], acc[m][n], 0, 0, 0);
            }
#pragma unroll
            for (int m = 0; m < 2; ++m) { const int q = 32 * wq + 16 * m + fr; const float bq = m == 0 ? bq0 : bq1;
#pragma unroll
                for (int n = 0; n < 4; ++n) { const int c = 64 * wcn + 16 * n + 4 * fq;
                    const u32x2 u2 = uw[m][n];
                    const float o0 = gelu_tanh(bf_lo(u2.x)) * (acc[m][n][0] + bq), o1 = gelu_tanh(bf_hi(u2.x)) * (acc[m][n][1] + bq),
                                o2 = gelu_tanh(bf_lo(u2.y)) * (acc[m][n][2] + bq), o3 = gelu_tanh(bf_hi(u2.y)) * (acc[m][n][3] + bq);
                    u32x2 ow; ow.x = cvt_pk_bf16(o0, o1); ow.y = cvt_pk_bf16(o2, o3);
                    *(u32x2*)(BR + (size_t)(r0 + q) * 2560 + 1536 + gq * 128 + c) = ow; } }
        }
        __syncthreads();
    }
}

__device__ __forceinline__ void thin_c(Frame& F, int l, int g) {
    const Grp gr = grp_of(g);
    unsigned char* gb = F.ws + WS_G;
    bf16_t* QB = (bf16_t*)(gb + G_Q); const bf16_t* KN = (const bf16_t*)(gb + G_KN); bf16_t* KB = (bf16_t*)(gb + G_K); const bf16_t* Z = (const bf16_t*)(gb + G_Z);
    const bf16_t* KP = (const bf16_t*)(F.ws + WS_KPE);
    const float* qn = F.in[I_QN] + l * QKH; const float* kn = F.in[I_KN] + l * QKH;
    const int lane = F.lane, hd = lane >> 2, j4 = lane & 3;
    const float QSCALE = 0.10206207261596577f * 1.4426950408889634f;
    float qw[32], kw[32];
#pragma unroll
    for (int i = 0; i < 16; ++i) { qw[i] = qn[16 * j4 + i]; kw[i] = kn[16 * j4 + i]; }
#pragma unroll
    for (int i = 0; i < 8; ++i) { qw[16 + i] = qn[64 + 8 * j4 + i]; qw[24 + i] = qn[64 + 8 * (j4 ^ 1) + i]; kw[16 + i] = kn[64 + 8 * j4 + i]; kw[24 + i] = kn[64 + 8 * (j4 ^ 1) + i]; }
    struct Row { u32x4 qa, qb, qo, qp, ka, kb, ko, kp; u32x2 z0, z1, z2; };
#define TC_LOAD(R, r) do { const bf16_t* qp_ = QB + (size_t)(r) * 1536 + hd * QKH; const bf16_t* zr_ = Z + (size_t)(r) * 4096; const bf16_t* kp_ = KN + (size_t)(r) * 1024 + hd * 64; const bf16_t* pe_ = KP + (size_t)(gr.row0 + (r)) * 32; \
        R.qa = *(const u32x4*)(qp_ + 16 * j4); R.qb = *(const u32x4*)(qp_ + 16 * j4 + 8); R.qo = *(const u32x4*)(qp_ + 64 + 8 * j4); R.qp = *(const u32x4*)(qp_ + 64 + 8 * (j4 ^ 1)); \
        R.z0 = *(const u32x2*)(zr_ + 12 * lane); R.z1 = *(const u32x2*)(zr_ + 12 * lane + 4); R.z2 = *(const u32x2*)(zr_ + 12 * lane + 8); \
        R.ka = *(const u32x4*)(kp_ + 16 * j4); R.kb = *(const u32x4*)(kp_ + 16 * j4 + 8); R.ko = *(const u32x4*)(pe_ + 8 * j4); R.kp = *(const u32x4*)(pe_ + 8 * (j4 ^ 1)); } while (0)
#define TC_UNPACK(W_, V_) do { const u32x4 t_ = (W_); V_[0] = bf_lo(t_.x); V_[1] = bf_hi(t_.x); V_[2] = bf_lo(t_.y); V_[3] = bf_hi(t_.y); V_[4] = bf_lo(t_.z); V_[5] = bf_hi(t_.z); V_[6] = bf_lo(t_.w); V_[7] = bf_hi(t_.w); } while (0)
#define TC_ROPE_TAB(pos) float cs[8] = {1.f,1.f,1.f,1.f,1.f,1.f,1.f,1.f}, sn[8] = {0.f,0.f,0.f,0.f,0.f,0.f,0.f,0.f}; \
        if (rope) { const float pv = (float)((j4 >> 1) == 0 ? ((pos) >> 6) : ((pos) & 63)); \
            _Pragma("unroll") for (int f = 0; f < 8; ++f) { const float ang = pv * __builtin_amdgcn_exp2f(-1.6609640474436813f * (float)f); cs[f] = __cosf(ang); sn[f] = __sinf(ang); } }
#define TC_FINISH(a, b, o, p, wv, scale, dst) do { float ss = 0.f; \
        _Pragma("unroll") for (int i = 0; i < 8; ++i) ss += a[i] * a[i] + b[i] * b[i] + o[i] * o[i]; \
        ss = quad_sum(ss); \
        const float rn = rsqrtf(ss * (1.0f / QKH) + EPS) * (scale); \
        _Pragma("unroll") for (int i = 0; i < 8; ++i) { a[i] *= rn * wv[i]; b[i] *= rn * wv[8 + i]; o[i] *= rn * wv[16 + i]; p[i] *= rn * wv[24 + i]; } \
        if (rope) { _Pragma("unroll") for (int i = 0; i < 8; ++i) o[i] = (j4 & 1) ? o[i] * cs[i] + p[i] * sn[i] : o[i] * cs[i] - p[i] * sn[i]; } \
        store8((dst) + 16 * j4, a); store8((dst) + 16 * j4 + 8, b); store8((dst) + 64 + 8 * j4, o); } while (0)
#define TC_COMPUTE(R, r) do { const bool rope = (g != 0); const int pos = (r) % gr.L; TC_ROPE_TAB(pos) \
        float s2 = 0.f; { const float a0 = bf_lo(R.z0.x), a1 = bf_hi(R.z0.x), a2 = bf_lo(R.z0.y), a3 = bf_hi(R.z0.y), a4 = bf_lo(R.z1.x), a5 = bf_hi(R.z1.x), a6 = bf_lo(R.z1.y), a7 = bf_hi(R.z1.y), a8 = bf_lo(R.z2.x), a9 = bf_hi(R.z2.x), a10 = bf_lo(R.z2.y), a11 = bf_hi(R.z2.y); \
            s2 = ((a0 * a0 + a1 * a1) + (a2 * a2 + a3 * a3)) + ((a4 * a4 + a5 * a5) + (a6 * a6 + a7 * a7)) + ((a8 * a8 + a9 * a9) + (a10 * a10 + a11 * a11)); } \
        const float rq = rsqrtf(wave_sum(s2) * (1.0f / QLORA) + EPS); \
        { float a[8], b[8], o[8], p[8]; TC_UNPACK(R.qa, a); TC_UNPACK(R.qb, b); TC_UNPACK(R.qo, o); TC_UNPACK(R.qp, p); \
          _Pragma("unroll") for (int i = 0; i < 8; ++i) { a[i] *= rq; b[i] *= rq; o[i] *= rq; p[i] *= rq; } \
          bf16_t* qd = QB + (size_t)(r) * 1536 + hd * QKH; TC_FINISH(a, b, o, p, qw, QSCALE, qd); } \
        { float a[8], b[8], o[8], p[8]; TC_UNPACK(R.ka, a); TC_UNPACK(R.kb, b); TC_UNPACK(R.ko, o); TC_UNPACK(R.kp, p); \
          bf16_t* kd = KB + (size_t)(r) * 1536 + hd * QKH; TC_FINISH(a, b, o, p, kw, 1.0f, kd); } } while (0)
    {
        Row R0, R1; int r = F.gw;
        if (r < gr.rows) TC_LOAD(R0, r);
        for (; r < gr.rows; r += 2 * F.ngw) {
            const int r1 = r + F.ngw, r2 = r + 2 * F.ngw;
            if (r1 < gr.rows) TC_LOAD(R1, r1);
            TC_COMPUTE(R0, r);
            if (r2 < gr.rows) TC_LOAD(R0, r2);
            if (r1 < gr.rows) TC_COMPUTE(R1, r1);
        }
    }
    for (int r = gr.rows + F.gw; r < gr.tkv; r += F.ngw) {
        const bool rope = false; float cs[8] = {1.f,1.f,1.f,1.f,1.f,1.f,1.f,1.f}, sn[8] = {0.f,0.f,0.f,0.f,0.f,0.f,0.f,0.f};
        const bf16_t* kp = KN + (size_t)r * 1024 + hd * 64;
        float a[8], b[8], o[8], p[8];
        load8(kp + 16 * j4, a); load8(kp + 16 * j4 + 8, b);
        { const int ci = r - gr.rows, sq = ci >> 8, pp = ci & 255, bb = 4 * (g - 1) + sq; const float* pe = F.in[I_CKPE] + (((size_t)bb * 2 + l) * 256 + pp) * 32;
#pragma unroll
          for (int i = 0; i < 8; ++i) { o[i] = pe[8 * j4 + i]; p[i] = pe[8 * (j4 ^ 1) + i]; } }
        bf16_t* kd = KB + (size_t)r * 1536 + hd * QKH; TC_FINISH(a, b, o, p, kw, 1.0f, kd);
    }
#undef TC_LOAD
#undef TC_UNPACK
#undef TC_ROPE_TAB
#undef TC_FINISH
#undef TC_COMPUTE
}

__device__ __forceinline__ void attn_phase(Frame& F, int g) {
    const Grp gr = grp_of(g);
    unsigned char* gb = F.ws + WS_G;
    const bf16_t* Q = (const bf16_t*)(gb + G_Q); const bf16_t* K = (const bf16_t*)(gb + G_K); const bf16_t* VT = (const bf16_t*)(gb + G_VT); bf16_t* BR = (bf16_t*)(gb + G_BR);
    constexpr int KS = 208, VS = 136, KBUF = 64 * KS, VBUF = 64 * VS;
    LAS unsigned char* kl = F.lds; LAS unsigned char* vl = F.lds + 2 * KBUF;
    const int tid = F.tid, lane = F.lane, wid = F.wave, r32 = lane & 31, hh = lane >> 5;
    const bool late = wid >= 4;
    const int qblocks = gr.L >> 8, nunits = gr.nseq * NH * qblocks, ntl = gr.L >> 6, nt = (gr.L + gr.C) >> 6;
    const int vcu = (F.G & 7) == 0 ? (F.bx & 7) * (F.G >> 3) + (F.bx >> 3) : F.bx;
    const int k0key = tid / 12, k0part = tid % 12, k1key = (tid + 512) / 12, k1part = (tid + 512) % 12; const bool k1v = tid < 256;
    const int vd = tid >> 3, vpart = tid & 7;
#define ATT_LOADG(t, Kh_, Vh_, srow0_, crow0_, kr0, kr1, vr) do { if ((t) < nt) { const int kb_ = (t) < ntl ? (srow0_) + 64 * (t) : (crow0_) + 64 * ((t) - ntl); \
        kr0 = *(const u32x4*)((Kh_) + (size_t)(kb_ + k0key) * 1536 + 8 * k0part); if (k1v) kr1 = *(const u32x4*)((Kh_) + (size_t)(kb_ + k1key) * 1536 + 8 * k1part); \
        vr = *(const u32x4*)((Vh_) + kb_); } } while (0)
#define ATT_UNIT_IDX(u_, qb_, head_, srow0_, crow0_) const int qb_ = (u_) % qblocks, sh##qb_ = (u_) / qblocks, head_ = sh##qb_ % NH, sq##qb_ = sh##qb_ / NH, srow0_ = sq##qb_ * gr.L, crow0_ = gr.rows + sq##qb_ * gr.C
#define ATT_QLOAD(qb_, head_, srow0_) do { const bf16_t* qp_ = Q + (size_t)((srow0_) + 256 * (qb_) + 32 * wid + r32) * 1536 + (head_) * QKH + 8 * hh; \
        _Pragma("unroll") for (int s = 0; s < 6; ++s) qf[s] = *(const bf16x8*)(qp_ + 16 * s); } while (0)
    bf16x8 qf[6];
    u32x4 ka0, ka1 = {0u, 0u, 0u, 0u}, va_, kb0, kb1 = {0u, 0u, 0u, 0u}, vb_;
    volatile LAS unsigned* flagw = (volatile LAS unsigned*)(F.lds + LDS_MISC) + 48;
    if (tid == 0) { flagw[0] = 0u; flagw[1] = 0u; }
    if (vcu < nunits) { ATT_UNIT_IDX(vcu, qb0, head0, srow00, crow00); ATT_QLOAD(qb0, head0, srow00);
        ATT_LOADG(0, K + head0 * QKH, VT + (size_t)(head0 * 64 + vd) * gr.tkv + 8 * vpart, srow00, crow00, ka0, ka1, va_); }
    unsigned par = 0;
    for (int un = vcu; un < nunits; un += F.G, par ^= 1u) {
        ATT_UNIT_IDX(un, qb, head, srow0, crow0);
        const bf16_t* Kh = K + head * QKH; const bf16_t* Vh = VT + (size_t)(head * 64 + vd) * gr.tkv + 8 * vpart;
#define ATT_LOAD(t, kr0, kr1, vr) ATT_LOADG(t, Kh, Vh, srow0, crow0, kr0, kr1, vr)
#define ATT_STORE(t, kbo, vbo, kr0, kr1, vr) do { if ((t) < nt) { *(LAS u32x4*)(kl + (kbo) + k0key * KS + 16 * k0part) = kr0; if (k1v) *(LAS u32x4*)(kl + (kbo) + k1key * KS + 16 * k1part) = kr1; \
        *(LAS u32x2*)(vl + (vbo) + vd * VS + 16 * vpart) = (u32x2){vr.x, vr.y}; *(LAS u32x2*)(vl + (vbo) + vd * VS + 16 * vpart + 8) = (u32x2){vr.z, vr.w}; } } while (0)
        const f32x16 z16 = {0.f,0.f,0.f,0.f,0.f,0.f,0.f,0.f,0.f,0.f,0.f,0.f,0.f,0.f,0.f,0.f};
        float m_run, l_run, ts_prev; bool first;
        f32x16 negm, o0, o1, p0, p1;
        u32x4 pw[2][2];
#define ATT_X(kbo) do { LAS unsigned char* kb = kl + (kbo); \
            _Pragma("unroll") for (int s = 0; s < 6; ++s) { \
                const bf16x8 ka = *(const LAS bf16x8*)(kb + r32 * KS + 32 * s + 16 * hh), kc = *(const LAS bf16x8*)(kb + (32 + r32) * KS + 32 * s + 16 * hh); \
                p0 = __builtin_amdgcn_mfma_f32_32x32x16_bf16(ka, qf[s], s == 0 ? negm : p0, 0, 0, 0); p1 = __builtin_amdgcn_mfma_f32_32x32x16_bf16(kc, qf[s], s == 0 ? negm : p1, 0, 0, 0); } } while (0)
#define ATT_YS() do { float mx = p0[0]; \
            _Pragma("unroll") for (int i = 1; i < 16; ++i) mx = fmaxf(mx, p0[i]); \
            _Pragma("unroll") for (int i = 0; i < 16; ++i) mx = fmaxf(mx, p1[i]); \
            { auto rr = __builtin_amdgcn_permlane32_swap(__float_as_uint(mx), __float_as_uint(mx), false, false); mx = fmaxf(__uint_as_float(rr[0]), __uint_as_float(rr[1])); } \
            if (first || __builtin_amdgcn_ballot_w64(mx > 5.0f) != 0ull) {            \
                const float dl = first ? mx : fmaxf(mx, 0.f); const float al = __builtin_amdgcn_exp2f(-dl); \
                m_run += dl; l_run *= al; o0 *= al; o1 *= al; p0 = p0 - dl; p1 = p1 - dl; \
                _Pragma("unroll") for (int i = 0; i < 16; ++i) negm[i] = -m_run; first = false; } \
            _Pragma("unroll") for (int i = 0; i < 16; ++i) { p0[i] = __builtin_amdgcn_exp2f(p0[i]); p1[i] = __builtin_amdgcn_exp2f(p1[i]); } \
            { const f32x16 s16 = p0 + p1; \
              const f32x4 s4 = (f32x4){s16[0], s16[1], s16[2], s16[3]} + (f32x4){s16[4], s16[5], s16[6], s16[7]} + (f32x4){s16[8], s16[9], s16[10], s16[11]} + (f32x4){s16[12], s16[13], s16[14], s16[15]}; \
              l_run += (s4[0] + s4[1]) + (s4[2] + s4[3]); } \
            _Pragma("unroll") for (int s2 = 0; s2 < 2; ++s2) { \
                pw[0][s2] = (u32x4){cvt_pk_bf16(p0[8 * s2], p0[8 * s2 + 1]), cvt_pk_bf16(p0[8 * s2 + 2], p0[8 * s2 + 3]), cvt_pk_bf16(p0[8 * s2 + 4], p0[8 * s2 + 5]), cvt_pk_bf16(p0[8 * s2 + 6], p0[8 * s2 + 7])}; \
                pw[1][s2] = (u32x4){cvt_pk_bf16(p1[8 * s2], p1[8 * s2 + 1]), cvt_pk_bf16(p1[8 * s2 + 2], p1[8 * s2 + 3]), cvt_pk_bf16(p1[8 * s2 + 4], p1[8 * s2 + 5]), cvt_pk_bf16(p1[8 * s2 + 6], p1[8 * s2 + 7])}; } } while (0)
#define ATT_YF() do { \
            if (first) { float mx = p0[0]; \
                _Pragma("unroll") for (int i = 1; i < 16; ++i) mx = fmaxf(mx, p0[i]); \
                _Pragma("unroll") for (int i = 0; i < 16; ++i) mx = fmaxf(mx, p1[i]); \
                { auto rr = __builtin_amdgcn_permlane32_swap(__float_as_uint(mx), __float_as_uint(mx), false, false); mx = fmaxf(__uint_as_float(rr[0]), __uint_as_float(rr[1])); } \
                m_run = mx; p0 = p0 - mx; p1 = p1 - mx; \
                _Pragma("unroll") for (int i = 0; i < 16; ++i) negm[i] = -m_run; first = false; } \
            else if (__builtin_amdgcn_ballot_w64(!(ts_prev < ATT_BIG)) != 0ull) { \
                float tsr; { auto rr = __builtin_amdgcn_permlane32_swap(__float_as_uint(ts_prev), __float_as_uint(ts_prev), false, false); tsr = __uint_as_float(rr[0]) + __uint_as_float(rr[1]); }     \
                const float dl = !(tsr < ATT_BIG) ? (float)((int)((__float_as_uint(tsr) >> 23) & 255u) - 127) : 0.f; const float al = __builtin_amdgcn_exp2f(-dl); \
                m_run += dl; l_run *= al; o0 *= al; o1 *= al; p0 = p0 - dl; p1 = p1 - dl; \
                _Pragma("unroll") for (int i = 0; i < 16; ++i) negm[i] = -m_run; } \
            _Pragma("unroll") for (int i = 0; i < 16; ++i) { p0[i] = __builtin_amdgcn_exp2f(p0[i]); p1[i] = __builtin_amdgcn_exp2f(p1[i]); } \
            { const f32x16 s16 = p0 + p1; \
              const f32x4 s4 = (f32x4){s16[0], s16[1], s16[2], s16[3]} + (f32x4){s16[4], s16[5], s16[6], s16[7]} + (f32x4){s16[8], s16[9], s16[10], s16[11]} + (f32x4){s16[12], s16[13], s16[14], s16[15]}; \
              ts_prev = (s4[0] + s4[1]) + (s4[2] + s4[3]); l_run += ts_prev; } \
            _Pragma("unroll") for (int s2 = 0; s2 < 2; ++s2) { \
                pw[0][s2] = (u32x4){cvt_pk_bf16(p0[8 * s2], p0[8 * s2 + 1]), cvt_pk_bf16(p0[8 * s2 + 2], p0[8 * s2 + 3]), cvt_pk_bf16(p0[8 * s2 + 4], p0[8 * s2 + 5]), cvt_pk_bf16(p0[8 * s2 + 6], p0[8 * s2 + 7])}; \
                pw[1][s2] = (u32x4){cvt_pk_bf16(p1[8 * s2], p1[8 * s2 + 1]), cvt_pk_bf16(p1[8 * s2 + 2], p1[8 * s2 + 3]), cvt_pk_bf16(p1[8 * s2 + 4], p1[8 * s2 + 5]), cvt_pk_bf16(p1[8 * s2 + 6], p1[8 * s2 + 7])}; } } while (0)
#define ATT_Z(vbo) do { LAS unsigned char* vb = vl + (vbo); \
            _Pragma("unroll") for (int kbk = 0; kbk < 2; ++kbk) \
            _Pragma("unroll") for (int s2 = 0; s2 < 2; ++s2) { const int kbase = (32 * kbk + 16 * s2 + 4 * hh) * 2; \
                    const u32x2 a0 = *(const LAS u32x2*)(vb + r32 * VS + kbase), a1 = *(const LAS u32x2*)(vb + r32 * VS + kbase + 16); \
                    const u32x2 c0 = *(const LAS u32x2*)(vb + (32 + r32) * VS + kbase), c1 = *(const LAS u32x2*)(vb + (32 + r32) * VS + kbase + 16); \
                    const u32x4 va = {a0.x, a0.y, a1.x, a1.y}, vc = {c0.x, c0.y, c1.x, c1.y}; \
                    const bf16x8 pb = __builtin_bit_cast(bf16x8, pw[kbk][s2]); \
                    o0 = __builtin_amdgcn_mfma_f32_32x32x16_bf16(__builtin_bit_cast(bf16x8, va), pb, o0, 0, 0, 0); \
                    o1 = __builtin_amdgcn_mfma_f32_32x32x16_bf16(__builtin_bit_cast(bf16x8, vc), pb, o1, 0, 0, 0); } } while (0)
        int kcur, vprev, vcur, vnext;
#define ATT_ROT() do { kcur ^= KBUF; vprev = vcur; vcur = vnext; vnext = (vnext == 2 * VBUF) ? 0 : vnext + VBUF; } while (0)
#define ATT_UNIT(YM) do { m_run = 0.f; l_run = 0.f; ts_prev = 0.f; first = true; negm = z16; o0 = z16; o1 = z16; p0 = z16; p1 = z16; \
        ATT_STORE(0, 0, 0, ka0, ka1, va_); ATT_LOAD(1, kb0, kb1, vb_); \
        __syncthreads(); \
        kcur = 0; vprev = 2 * VBUF; vcur = 0; vnext = VBUF; \
        if (!late) { \
            for (int t = 0; t < nt; t += 2) { \
                ATT_LOAD(t + 2, ka0, ka1, va_); \
                ATT_X(kcur); YM(); ATT_Z(vcur); \
                ATT_STORE(t + 1, kcur ^ KBUF, vnext, kb0, kb1, vb_); \
                __syncthreads(); ATT_ROT(); \
                ATT_LOAD(t + 3, kb0, kb1, vb_); \
                ATT_X(kcur); YM(); ATT_Z(vcur); \
                ATT_STORE(t + 2, kcur ^ KBUF, vnext, ka0, ka1, va_); \
                __syncthreads(); ATT_ROT(); \
            } \
        } else { \
            for (int t = 0; t < nt; t += 2) { \
                ATT_LOAD(t + 2, ka0, ka1, va_); \
                if (t > 0) { YM(); ATT_Z(vprev); } \
                ATT_X(kcur); \
                ATT_STORE(t + 1, kcur ^ KBUF, vnext, kb0, kb1, vb_); \
                __syncthreads(); ATT_ROT(); \
                ATT_LOAD(t + 3, kb0, kb1, vb_); \
                YM(); ATT_Z(vprev); \
                ATT_X(kcur); \
                ATT_STORE(t + 2, kcur ^ KBUF, vnext, ka0, ka1, va_); \
                __syncthreads(); ATT_ROT(); \
            } \
            YM(); ATT_Z(vprev); \
        } \
        } while (0)
        ATT_UNIT(ATT_YF);
        float chk; u32x2 ow[4][2];
#define ATT_FINISH() do { chk = l_run; \
            _Pragma("unroll") for (int i = 0; i < 16; ++i) chk += __builtin_fabsf(o0[i]) + __builtin_fabsf(o1[i]); \
            float lr; { auto rr = __builtin_amdgcn_permlane32_swap(__float_as_uint(l_run), __float_as_uint(l_run), false, false); lr = __uint_as_float(rr[0]) + __uint_as_float(rr[1]); } \
            const float il = 1.0f / lr; \
            _Pragma("unroll") for (int gq = 0; gq < 4; ++gq) { \
                ow[gq][0].x = cvt_pk_bf16(o0[4 * gq] * il, o0[4 * gq + 1] * il); ow[gq][0].y = cvt_pk_bf16(o0[4 * gq + 2] * il, o0[4 * gq + 3] * il); \
                ow[gq][1].x = cvt_pk_bf16(o1[4 * gq] * il, o1[4 * gq + 1] * il); ow[gq][1].y = cvt_pk_bf16(o1[4 * gq + 2] * il, o1[4 * gq + 3] * il); } } while (0)
#define ATT_PREFETCH_NEXT() do { if (un + F.G < nunits) { ATT_UNIT_IDX(un + F.G, qbn, headn, srow0n, crow0n); ATT_QLOAD(qbn, headn, srow0n); \
            ATT_LOADG(0, K + headn * QKH, VT + (size_t)(headn * 64 + vd) * gr.tkv + 8 * vpart, srow0n, crow0n, ka0, ka1, va_); } } while (0)
        ATT_FINISH();
        ATT_PREFETCH_NEXT();
        {
            if (__builtin_amdgcn_ballot_w64(!(chk < ATT_CHK)) != 0ull && lane == 0) flagw[par] = 1u;
            __syncthreads();
            const unsigned redo = flagw[par];
            if (tid == 0) flagw[par ^ 1u] = 0u;
            if (redo) { ATT_QLOAD(qb, head, srow0); ATT_LOAD(0, ka0, ka1, va_); ATT_UNIT(ATT_YS); ATT_FINISH(); ATT_PREFETCH_NEXT(); __syncthreads(); }
        }
#undef ATT_PREFETCH_NEXT
#undef ATT_FINISH
#undef ATT_ROT
#undef ATT_LOAD
#undef ATT_STORE
#undef ATT_X
#undef ATT_YS
#undef ATT_YF
#undef ATT_UNIT
#undef ATT_Z
        bf16_t* op = BR + (size_t)(srow0 + 256 * qb + 32 * wid + r32) * 2560 + head * 64;
#pragma unroll
        for (int gq = 0; gq < 4; ++gq) { const int d0 = 8 * gq + 4 * hh; *(u32x2*)(op + d0) = ow[gq][0]; *(u32x2*)(op + 32 + d0) = ow[gq][1]; }
    }
    __syncthreads();
#undef ATT_LOADG
#undef ATT_UNIT_IDX
#undef ATT_QLOAD
}

constexpr int STEPS_PER_GROUP = 7, STEPS_PER_LAYER = 2 + NGRP * STEPS_PER_GROUP + 3, NSTEPS = NLAYER * STEPS_PER_LAYER;

__global__ void __launch_bounds__(NTHR, 2) mk_fwd(Args args) {
    extern __shared__ __attribute__((aligned(16))) unsigned char lds_raw[];
    Frame F;
    F.lds = (LAS unsigned char*)lds_raw;
    F.tid = threadIdx.x; F.lane = F.tid & 63; F.wave = __builtin_amdgcn_readfirstlane(F.tid >> 6);
    F.bx = blockIdx.x; F.G = gridDim.x; F.gw = F.bx * NWAVE + F.wave; F.ngw = F.G * NWAVE;
    F.in = args.in; F.out = args.out; F.ws = args.ws;
    volatile LAS unsigned* misc = (volatile LAS unsigned*)(F.lds + LDS_MISC);
    if (F.tid < 64) misc[F.tid] = 0u;
    __syncthreads();
    XcdBarrier bar; bar.bar = (unsigned*)(F.ws + WS_CTL) + 1024; bar.x = 0; bar.st = misc + 8;
#if !MK_MULTI
    bar = xcd_barrier_post((unsigned*)(F.ws + WS_CTL) + 1024, misc + 8);
#endif
    const int lo = args.step_lo, hi = args.step_hi;
#define IN(s) (lo <= (s) && (s) < hi)
#if MK_MULTI
#define SEAM(s) do { } while (0)
#else
#define SEAM(s) do { if (IN(s) && IN((s) + 1)) xcd_barrier(bar); } while (0)
#endif
    for (int l0 = 0; l0 < NLAYER; ++l0) {
        const int sp = l0 * STEPS_PER_LAYER, sl = sp + 1;
        if (IN(sp)) { Frame P = fresh(F); int l = l0; LAUNDER_S(l); p0_prologue(P, l); } SEAM(sp);
        if (IN(sl)) { { Frame P = fresh(F); int l = l0; LAUNDER_S(l);
            if (l == 0) thin_norm<true, false>(P, l, P.in[I_XP], P.in[I_XS], P.in[I_NMIX] + l * DM, 0, 1);
            else thin_norm<true, true>(P, l, nullptr, nullptr, P.in[I_NMIX] + l * DM, 0, 1); } } SEAM(sl);
        for (int g0 = 0; g0 < NGRP; ++g0) {
            const int sg = sl + 1 + g0 * STEPS_PER_GROUP;
            if (IN(sg + 0)) { {
                Frame P = fresh(F); int l = l0, g = g0; LAUNDER_S(l); LAUNDER_S(g); const Grp gr = grp_of(g);
                unsigned char* wl = P.ws + WS_W0; unsigned char* gb = P.ws + WS_G;
                pg8::Prob p{(const bf16_t*)(P.ws + WS_H) + (size_t)gr.row0 * DM, (const bf16_t*)(wl + OFF_WIN), DM, DM, DM};
                pg8::StaticOrder S; S.init(gr.rows, 12288, P.G, P.bx, WGM_BIG);
                pg8::EpiZ E{(bf16_t*)(gb + G_Z), (bf16_t*)(gb + G_GATE), P.in[I_BGATE] + (size_t)l * 8192};
                pg8::gemm_phase(P.lds, p, S, E);
            } } SEAM(sg + 0);
            if (IN(sg + 1)) { { Frame P = fresh(F); int l = l0, g = g0; LAUNDER_S(l); LAUNDER_S(g); thin_b(P, l, g); } } SEAM(sg + 1);
            if (IN(sg + 2)) { {
                Frame P = fresh(F); int l = l0, g = g0; LAUNDER_S(l); LAUNDER_S(g); const Grp gr = grp_of(g);
                unsigned char* wl = P.ws + WS_W0; unsigned char* gb = P.ws + WS_G;
                { pg8::Prob p{(const bf16_t*)(gb + G_Z), (const bf16_t*)(wl + OFF_WUQ), 4096, QLORA, QLORA};
                  pg8::StaticOrder S; S.init(gr.rows, 1536, P.G, P.bx);
                  pg8::EpiStore E{(bf16_t*)(gb + G_Q), 1536};
                  pg8::gemm_phase(P.lds, p, S, E); }
                { pg8::Prob p{(const bf16_t*)(gb + G_CKV), (const bf16_t*)(wl + OFF_WUK), KVL, KVL, KVL};
                  pg8::StaticOrder S; S.init(gr.tkv, 1024, P.G, (P.bx + (g == 0 ? 160 : 128)) % P.G);
                  pg8::EpiStore E{(bf16_t*)(gb + G_KN), 1024};
                  pg8::gemm_phase(P.lds, p, S, E); }
                { pg8::Prob p{(const bf16_t*)(wl + OFF_WUV), (const bf16_t*)(gb + G_CKV), KVL, KVL, KVL};
                  pg8::StaticOrder S; S.init(1024, gr.tkv, P.G, (P.bx + (g == 0 ? 96 : 112)) % P.G);
                  pg8::EpiStore E{(bf16_t*)(gb + G_VT), gr.tkv};
                  pg8::gemm_phase(P.lds, p, S, E); }
            } } SEAM(sg + 2);
            if (IN(sg + 3)) { Frame P = fresh(F); int l = l0, g = g0; LAUNDER_S(l); LAUNDER_S(g); thin_c(P, l, g); } SEAM(sg + 3);
            if (IN(sg + 4)) { { Frame P = fresh(F); int g = g0; LAUNDER_S(g); attn_phase(P, g); } } SEAM(sg + 4);
            if (IN(sg + 5)) { {
                Frame P = fresh(F); int l = l0, g = g0; LAUNDER_S(l); LAUNDER_S(g); const Grp gr = grp_of(g);
                unsigned char* wl = P.ws + WS_W0; unsigned char* gb = P.ws + WS_G;
                pg8::ProbSeg p{(const bf16_t*)(gb + G_BR), (const bf16_t*)(wl + OFF_WBR), 2560, 2560};
                pg8::SegOrder S; S.init(gr.rows, DM, P.G, P.bx, WGM_SMALL);
                pg8::EpiMerge E{(const unsigned char*)(gb + G_GATE), (bf16_t*)(gb + G_M)};
                pg8::gemm_phase(P.lds, p, S, E);
            } } SEAM(sg + 5);
            if (IN(sg + 6)) {
                Frame P = fresh(F); int l = l0, g = g0; LAUNDER_S(l); LAUNDER_S(g); const Grp gr = grp_of(g);
                unsigned char* wl = P.ws + WS_W0; unsigned char* gb = P.ws + WS_G;
                const float* xc = l == 0 ? P.in[I_XP] : nullptr; const float* xl = l == 0 ? P.in[I_XS] : nullptr;
                const float* modl = (const float*)(P.ws + WS_MOD) + (size_t)l * NCOND * 12288;
                pg8::Prob p{(const bf16_t*)(gb + G_M), (const bf16_t*)(wl + OFF_WOUT), DM, DM, DM};
                pg8::StaticOrder S; S.init(gr.rows, DM, P.G, P.bx, WGM_SMALL);
                pg8::EpiResid E{xc, xl, (bf16_t*)(P.ws + WS_XB), nullptr, modl, 2, gr.row0};
                pg8::gemm_phase(P.lds, p, S, E);
            } SEAM(sg + 6);
        }
        const int sf = sl + 1 + NGRP * STEPS_PER_GROUP;
        if (IN(sf)) { { Frame P = fresh(F); int l = l0; LAUNDER_S(l);
            thin_norm<false, true>(P, l, nullptr, nullptr, P.in[I_NFFN] + l * DM, 3, 4); } } SEAM(sf);
        if (IN(sf + 1)) { {
            Frame P = fresh(F); int l = l0; LAUNDER_S(l); unsigned char* wl = P.ws + WS_W0;
            pg8::Prob p{(const bf16_t*)(P.ws + WS_H), (const bf16_t*)(wl + OFF_WFI), DM, DM, DM};
            pg8::StaticOrder S; S.init(TALL, 2 * DFF, P.G, P.bx, WGM_BIG);
            pg8::EpiSwiglu E{(bf16_t*)(P.ws + WS_ACT)};
            pg8::gemm_phase(P.lds, p, S, E);
        } } SEAM(sf + 1);
        if (IN(sf + 2)) {
            Frame P = fresh(F); int l = l0; LAUNDER_S(l); unsigned char* wl = P.ws + WS_W0; float* OUT = P.out;
            const float* modl = (const float*)(P.ws + WS_MOD) + (size_t)l * NCOND * 12288;
            pg8::Prob p{(const bf16_t*)(P.ws + WS_ACT), (const bf16_t*)(wl + OFF_WFO), DFF, DFF, DFF};
            pg8::StaticOrder S; S.init(TALL, DM, P.G, P.bx, WGM_SMALL);
            pg8::EpiResid E{nullptr, nullptr, (bf16_t*)(P.ws + WS_XB), l == NLAYER - 1 ? OUT : nullptr, modl, 5, 0};
            pg8::gemm_phase(P.lds, p, S, E);
        } SEAM(sf + 2);
    }
#undef IN
#undef SEAM
}

extern "C" void kernel_launch(void* const* d_in, const int* in_sizes, int n_in, void* d_out, int out_size, void* d_ws, size_t ws_size, hipStream_t stream) {
    static int grid = 0;
    if (grid == 0) {
        if (n_in != 31 || ws_size < WS_END) { fprintf(stderr, "kernel_launch: n_in %d ws %zu (need %zu)\n", n_in, ws_size, (size_t)WS_END); grid = -1; return; }
        int dev = 0, cus = 0;
        if (hipGetDevice(&dev) != hipSuccess || hipDeviceGetAttribute(&cus, hipDeviceAttributeMultiprocessorCount, dev) != hipSuccess) { grid = -1; return; }
        if (hipFuncSetAttribute((const void*)mk_fwd, hipFuncAttributeMaxDynamicSharedMemorySize, LDS_BYTES) != hipSuccess) { fprintf(stderr, "hipFuncSetAttribute failed\n"); grid = -1; return; }
        int per_cu = 0;
        (void)hipOccupancyMaxActiveBlocksPerMultiprocessor(&per_cu, (const void*)mk_fwd, NTHR, LDS_BYTES);
        (void)hipGetLastError();
        grid = cus < NWG ? cus : NWG;
        if (grid != NWG) fprintf(stderr, "kernel_launch: %d CUs, expected 256\n", cus);
    }
    if (grid < 0) return;
    (void)hipMemsetAsync((char*)d_ws + WS_CTL, 0, CTL_BYTES, stream);
    Args a{};
    for (int i = 0; i < 31; ++i) a.in[i] = (const float*)d_in[i];
    a.out = (float*)d_out; a.ws = (unsigned char*)d_ws;
#if MK_MULTI
    for (int s = 0; s < NSTEPS; ++s) { a.step_lo = s; a.step_hi = s + 1; hipLaunchKernelGGL(mk_fwd, dim3(grid), dim3(NTHR), LDS_BYTES, stream, a); }
#else
    a.step_lo = 0; a.step_hi = NSTEPS;
    hipLaunchKernelGGL(mk_fwd, dim3(grid), dim3(NTHR), LDS_BYTES, stream, a);
#endif
}
```

```cpp
#include <hip/hip_runtime.h>
#include <cstdio>
#include <cstdint>

#define LAS __attribute__((address_space(3)))
#define GAS __attribute__((address_space(1)))
typedef unsigned short bf16_t;
typedef short bf16x8 __attribute__((ext_vector_type(8)));
typedef float f32x2 __attribute__((ext_vector_type(2)));
typedef float f32x4 __attribute__((ext_vector_type(4)));
typedef float f32x16 __attribute__((ext_vector_type(16)));
typedef unsigned u32x2 __attribute__((ext_vector_type(2)));
typedef unsigned u32x4 __attribute__((ext_vector_type(4)));

#ifndef WGM_BIG
#define WGM_BIG 4
#endif
#ifndef WGM_SMALL
#define WGM_SMALL 4
#endif
#ifndef ATT_BIG
#define ATT_BIG 1.0995116e12f
#define ATT_CHK 1.0e37f
#endif
#ifndef MK_MULTI
#define MK_MULTI 0
#endif

constexpr int DM = 2048, TCTX = 4096, TLAT = 32768, TALL = TCTX + TLAT, NINW = 12320, DFF = 5632;
constexpr int NH = 16, QKH = 96, VH = 64, QLORA = 768, KVL = 256, ROPE = 32;
constexpr float EPS = 1e-6f;
constexpr int NLAYER = 2, NCOND = 9, NGRP = 3;
constexpr int GROWS = 16384, GKV = 17408;
constexpr int NWG = 256, NTHR = 512, NWAVE = 8;

constexpr size_t MiB = 1u << 20;
constexpr size_t WS_CTL = 0, CTL_BYTES = 1 * MiB;
constexpr size_t WS_MOD = 1 * MiB;
constexpr size_t WS_W0 = 2 * MiB;
constexpr size_t OFF_WIN = 0;
constexpr size_t OFF_WKPE = OFF_WIN + (size_t)12288 * 2048 * 2;
constexpr size_t OFF_WUQ = OFF_WKPE + (size_t)32 * 2048 * 2;
constexpr size_t OFF_WUK = OFF_WUQ + (size_t)1536 * 768 * 2;
constexpr size_t OFF_WUV = OFF_WUK + (size_t)1024 * 256 * 2;
constexpr size_t OFF_WSP = OFF_WUV + (size_t)1024 * 256 * 2;
constexpr size_t OFF_WBR = OFF_WSP + (size_t)4 * 128 * 128 * 2;
constexpr size_t OFF_WOUT = OFF_WBR + (size_t)2048 * 2560 * 2;
constexpr size_t OFF_WFI = OFF_WOUT + (size_t)2048 * 2048 * 2;
constexpr size_t OFF_WFO = OFF_WFI + (size_t)11264 * 2048 * 2;
constexpr size_t WL_BYTES = OFF_WFO + (size_t)2048 * 5632 * 2;
constexpr size_t WS_H = WS_W0 + WL_BYTES;
constexpr size_t WS_KPE = WS_H + (size_t)TALL * DM * 2;
constexpr size_t WS_G = WS_KPE + (size_t)TALL * 32 * 2;
constexpr size_t G_Z = 0;
constexpr size_t G_GATE = G_Z + (size_t)GROWS * 4096 * 2;
constexpr size_t G_Q = G_GATE + (size_t)GROWS * 8192;
constexpr size_t G_CKV = G_Q + (size_t)GROWS * 1536 * 2;
constexpr size_t G_KN = G_CKV + (size_t)GKV * 256 * 2;
constexpr size_t G_K = G_KN + (size_t)GKV * 1024 * 2;
constexpr size_t G_VT = G_K + (size_t)GKV * 1536 * 2;
constexpr size_t G_RQ = G_VT + (size_t)1024 * GKV * 2;
constexpr size_t G_BR = G_RQ + (size_t)GROWS * 4;
constexpr size_t G_M = G_BR + (size_t)GROWS * 2560 * 2;
constexpr size_t G_SCR = G_M + (size_t)GROWS * 2048 * 2;
constexpr size_t G_END = G_SCR;
constexpr size_t WS_ACT = WS_G;
static_assert((size_t)TALL * DFF * 2 <= G_END, "act overlay");
constexpr size_t WS_XB = WS_G + G_END;
constexpr size_t WS_END = WS_XB + (size_t)TALL * DM * 2;
static_assert(WS_END <= (size_t)1073741824, "workspace");
static_assert(WS_H % 256 == 0 && WS_G % 256 == 0 && G_SCR % 256 == 0 && OFF_WFO % 256 == 0 && WS_XB % 256 == 0, "align");

constexpr int LDS_MISC = 131072;
constexpr int LDS_BYTES = 147456;

typedef __bf16 bf16x2_t __attribute__((ext_vector_type(2)));
__device__ __forceinline__ unsigned cvt_pk_bf16(float lo, float hi) { const f32x2 v = {lo, hi}; const bf16x2_t b = __builtin_convertvector(v, bf16x2_t); return __builtin_bit_cast(unsigned, b); }
__device__ __forceinline__ float bf_lo(unsigned w) { return __uint_as_float(w << 16); }
__device__ __forceinline__ float bf_hi(unsigned w) { return __uint_as_float(w & 0xffff0000u); }
__device__ __forceinline__ float bf1(bf16_t b) { return __uint_as_float(((unsigned)b) << 16); }
template <int CTRL> __device__ __forceinline__ float dpp_f(float v) { return __builtin_bit_cast(float, __builtin_amdgcn_update_dpp(0, __builtin_bit_cast(int, v), CTRL, 0xf, 0xf, true)); }
__device__ __forceinline__ float quad_sum(float v) { v += dpp_f<0xB1>(v); v += dpp_f<0x4E>(v); return v; }
__device__ __forceinline__ float wave_sum(float v) {
    v = quad_sum(v);
    v += dpp_f<0x141>(v);
    v += dpp_f<0x140>(v);
    { auto rr = __builtin_amdgcn_permlane16_swap(__float_as_uint(v), __float_as_uint(v), false, false); v = __uint_as_float(rr[0]) + __uint_as_float(rr[1]); }
    { auto rr = __builtin_amdgcn_permlane32_swap(__float_as_uint(v), __float_as_uint(v), false, false); v = __uint_as_float(rr[0]) + __uint_as_float(rr[1]); }
    return v;
}
__device__ __forceinline__ float sigmoidf_(float x) { return __builtin_amdgcn_rcpf(1.0f + __expf(-x)); }
__device__ __forceinline__ float gelu_tanh(float x) {
    const float y2 = 1.5957691216057308f * (x + 0.044715f * x * x * x);
    return x * __builtin_amdgcn_rcpf(1.0f + __expf(-y2));
}
__device__ __forceinline__ void load8(const bf16_t* p, float (&v)[8]) { const u32x4 w = *(const u32x4*)p; v[0] = bf_lo(w.x); v[1] = bf_hi(w.x); v[2] = bf_lo(w.y); v[3] = bf_hi(w.y); v[4] = bf_lo(w.z); v[5] = bf_hi(w.z); v[6] = bf_lo(w.w); v[7] = bf_hi(w.w); }
__device__ __forceinline__ void store8(bf16_t* p, const float (&v)[8]) { u32x4 w; w.x = cvt_pk_bf16(v[0], v[1]); w.y = cvt_pk_bf16(v[2], v[3]); w.z = cvt_pk_bf16(v[4], v[5]); w.w = cvt_pk_bf16(v[6], v[7]); *(u32x4*)p = w; }
#define LDS_WAIT() asm volatile("s_waitcnt lgkmcnt(0)" ::: "memory")
#define VM_WAIT() asm volatile("s_waitcnt vmcnt(0)" ::: "memory")

#define XB_TMO      128
#define XB_XCNT(j)  (256  + 64 * (j))
#define XB_XSUB(j)  (1280 + 64 * (j))
#define XB_XGEN(j)  (2304 + 64 * (j))
#define XB_TOP      3328
#define XB_TOPGEN   3392
#define XCD_BAR_WORDS 3456
#define XB_SPIN_CAP (1u << 18)
__device__ __forceinline__ unsigned xb_ld(unsigned* p)              { return __hip_atomic_load(p, __ATOMIC_RELAXED, __HIP_MEMORY_SCOPE_AGENT); }
__device__ __forceinline__ unsigned xb_add(unsigned* p, unsigned v) { return __hip_atomic_fetch_add(p, v, __ATOMIC_RELAXED, __HIP_MEMORY_SCOPE_AGENT); }
__device__ __forceinline__ unsigned xb_xcc_id() { return (unsigned)__builtin_amdgcn_s_getreg((3 << 11) | 20) & 0xFu; }
#define XB_SPIN(cond, bar) do { unsigned _sp = 0; while (cond) { __builtin_amdgcn_s_sleep(1); \
    if ((++_sp & 255u) == 0u) { if (xb_ld(&(bar)[XB_TMO])) break; if (_sp > XB_SPIN_CAP) { atomicAdd(&(bar)[XB_TMO], 1u); break; } } } } while (0)
struct XcdBarrier { unsigned* bar; unsigned x; volatile LAS unsigned* st; };
__device__ __forceinline__ XcdBarrier xcd_barrier_post(unsigned* bar, volatile LAS unsigned* st) {
    XcdBarrier b; b.bar = bar; b.x = xb_xcc_id(); b.st = st;
    if (threadIdx.x == 0) (void)xb_add(&bar[XB_XCNT(b.x)], 1u);
    return b;
}
__device__ __forceinline__ void xcd_barrier_complete(unsigned* bar, unsigned x, unsigned& nloc, unsigned& nx) {
    const unsigned G = gridDim.x * gridDim.y * gridDim.z;
    unsigned sum, cnt, mine, sp = 0u;
    for (;;) {
        sum = 0u; cnt = 0u; mine = 0u;
#pragma unroll
        for (unsigned j = 0; j < 16; ++j) { const unsigned c = xb_ld(&bar[XB_XCNT(j)]); sum += c; cnt += (c > 0u) ? 1u : 0u; mine = (j == x) ? c : mine; }
        if (sum == G) break;
        __builtin_amdgcn_s_sleep(1);
        if ((++sp & 255u) == 0u) { if (xb_ld(&bar[XB_TMO])) break; if (sp > XB_SPIN_CAP) { atomicAdd(&bar[XB_TMO], 1u); break; } }
    }
    nloc = mine > 0u ? mine : 1u; nx = cnt > 0u ? cnt : 1u;
}
__device__ __forceinline__ void xcd_barrier(const XcdBarrier& b) {
    asm volatile("s_waitcnt vmcnt(0)" ::: "memory");
    __syncthreads();
    if (threadIdx.x == 0) {
        unsigned* bar = b.bar;
        __builtin_amdgcn_s_waitcnt(0);
        unsigned nloc = b.st[0], nx = b.st[1];
        if (nloc == 0u) { xcd_barrier_complete(bar, b.x, nloc, nx); b.st[0] = nloc; b.st[1] = nx; }
        const unsigned old = xb_add(&bar[XB_XSUB(b.x)], 1u);
        const unsigned gen = old / nloc;
        if (old + 1u == (gen + 1u) * nloc) {
            __builtin_amdgcn_fence(__ATOMIC_RELEASE, "agent");
            asm volatile("s_waitcnt vmcnt(0)" ::: "memory");
            const unsigned og = xb_add(&bar[XB_TOP], 1u);
            const unsigned tg = og / nx;
            if (og + 1u == (tg + 1u) * nx) xb_add(&bar[XB_TOPGEN], 1u);
            else XB_SPIN(xb_ld(&bar[XB_TOPGEN]) == tg, bar);
            __builtin_amdgcn_fence(__ATOMIC_ACQUIRE, "agent");
            xb_add(&bar[XB_XGEN(b.x)], 1u);
            asm volatile("s_waitcnt vmcnt(0)" ::: "memory");
        } else {
            XB_SPIN(xb_ld(&bar[XB_XGEN(b.x)]) == gen, bar);
            __builtin_amdgcn_fence(__ATOMIC_ACQUIRE, "agent");
            asm volatile("s_waitcnt vmcnt(0)" ::: "memory");
        }
    }
    __syncthreads();
}

namespace pg8 {
constexpr int BM = 256, BK = 64, HALF = 128, HTB = HALF * BK * 2, STAGE_BYTES = 8 * HTB, NXCD = 8;
__host__ __device__ __forceinline__ int lds_byte(int r, int c) { const int st = (r >> 4) * 2 + (c >> 5), rr = r & 15, cc = c & 31, ob = rr * 64 + cc * 2; return st * 1024 + (ob ^ (((ob >> 9) & 1) << 5)); }
__host__ __device__ __forceinline__ void stage_rc(int b, int& R, int& C) { const int st = b / 1024, sb = b % 1024, swz = sb ^ (((sb >> 9) & 1) << 5); R = (st >> 1) * 16 + swz / 64; C = (st & 1) * 32 + (swz % 64) / 2; }
__host__ __device__ __forceinline__ int perm32(int rho) { const int n = rho >> 4, i = rho & 15; return 8 * (i >> 2) + 4 * n + (i & 3); }

struct Unit { int pm, pn, seg; };
struct Prob {
    const bf16_t* A; const bf16_t* Bt; int lda, ldb, K;
    __device__ __forceinline__ const char* abase(const Unit& u) const { return (const char*)(A + (size_t)u.pm * BM * lda); }
    __device__ __forceinline__ const char* bbase(const Unit& u) const { return (const char*)(Bt + (size_t)u.pn * BM * ldb); }
    __device__ __forceinline__ int ntiles(const Unit&) const { return K / BK; }
};
struct ProbSeg {
    const bf16_t* A; const bf16_t* Bt; int lda, ldb;
    __device__ __forceinline__ int koff(int s) const { return s == 0 ? 0 : 512 + 512 * s; }
    __device__ __forceinline__ const char* abase(const Unit& u) const { return (const char*)(A + (size_t)u.pm * BM * lda + koff(u.seg)); }
    __device__ __forceinline__ const char* bbase(const Unit& u) const { return (const char*)(Bt + (size_t)u.pn * BM * ldb + koff(u.seg)); }
    __device__ __forceinline__ int ntiles(const Unit& u) const { return u.seg == 0 ? 16 : 8; }
};
struct StaticOrder {
    int nM, nN, nwg, G, c, WGM;
    __device__ __forceinline__ void init(int M, int N, int G_, int c_, int wgm = 4) { nM = M / BM; nN = N / BM; nwg = nM * nN; G = G_; c = c_; WGM = wgm; }
    __device__ __forceinline__ bool tile(long L, Unit& u) const {
        if (L >= nwg) return false;
        int wgid = (int)L; { const int q = nwg / NXCD, r = nwg % NXCD, xcd = wgid % NXCD, off = wgid / NXCD; wgid = (xcd < r ? xcd * (q + 1) : r * (q + 1) + (xcd - r) * q) + off; }
        const int nig = WGM * nN, gid = wgid / nig, fm = gid * WGM, gsz = (nM - fm) < WGM ? (nM - fm) : WGM;
        u.pm = fm + ((wgid % nig) % gsz); u.pn = (wgid % nig) / gsz; return true;
    }
    __device__ __forceinline__ bool next(int i, Unit& u) const { u.seg = 0; return tile((long)i * G + c, u); }
};
struct SegOrder : StaticOrder {
    __device__ __forceinline__ bool next(int i, Unit& u) const { u.seg = i & 3; return tile((long)(i >> 2) * G + c, u); }
};

typedef f32x4 Acc[2][2][4][2];

template <class Epi, class Sched, class P>
__device__ __forceinline__ void gemm_phase(LAS unsigned char* lds, const P g, const Sched& S, const Epi& E) {
    int tid = threadIdx.x; asm volatile("" : "+v"(tid));
    const int wid = __builtin_amdgcn_readfirstlane(tid >> 6), lane = tid & 63, wr = wid >> 2, wc = wid & 3, fr = lane & 15, fq = lane >> 4;
    unsigned voffA[2], voffB[2];
#pragma unroll
    for (int i = 0; i < 2; ++i) { int R, C; stage_rc(tid * 16 + i * 8192, R, C); const int Rb = Epi::PERM ? ((R & ~31) + perm32(R & 31)) : R;
        voffA[i] = (unsigned)(R * g.lda + C) * 2u; voffB[i] = (unsigned)(Rb * g.ldb + C) * 2u; }
    const size_t kstep = (size_t)(BK * 2);
    const size_t hstepA = (size_t)HALF * g.lda * 2, hstepB = (size_t)HALF * g.ldb * 2;
    const unsigned ldsw = (unsigned)wid * 1024u;
    const int aoff = lds_byte(wr * 64 + fr, fq * 8), boff = lds_byte(wc * 32 + fr, fq * 8);
#define PG8_SA(b, h) (((b) * 2 + (h)) * HTB)
#define PG8_SB(b, h) ((4 + (b) * 2 + (h)) * HTB)
#define PG8_STAGE(bufoff, gbase, voff) do { _Pragma("unroll") for (int _i = 0; _i < 2; ++_i) \
        __builtin_amdgcn_global_load_lds((const unsigned*)((const char*)(gbase) + (voff)[_i]), (LAS unsigned*)(lds + (bufoff) + ldsw + _i * 8192), 16, 0, 0); } while (0)
#define PG8_LDA(dst, b, h) do { _Pragma("unroll") for (int m = 0; m < 4; ++m) _Pragma("unroll") for (int k = 0; k < 2; ++k) dst[m][k] = *(const LAS bf16x8*)(lds + PG8_SA(b, h) + aoff + m * 2048 + k * 1024); } while (0)
#define PG8_LDB(dst, b, h) do { _Pragma("unroll") for (int n = 0; n < 2; ++n) _Pragma("unroll") for (int k = 0; k < 2; ++k) dst[n][k] = *(const LAS bf16x8*)(lds + PG8_SB(b, h) + boff + n * 2048 + k * 1024); } while (0)
#define PG8_MMA(ai, bj, At, Bt) do { __builtin_amdgcn_s_setprio(1); _Pragma("unroll") for (int m = 0; m < 4; ++m) _Pragma("unroll") for (int n = 0; n < 2; ++n) _Pragma("unroll") for (int k = 0; k < 2; ++k) \
        acc[ai][bj][m][n] = __builtin_amdgcn_mfma_f32_16x16x32_bf16(Bt[n][k], At[m][k], acc[ai][bj][m][n], 0, 0, 0); __builtin_amdgcn_s_setprio(0); } while (0)
#define PG8_WAIT_V(n) asm volatile("s_waitcnt vmcnt(" #n ")" ::: "memory")
#define PG8_WAIT_L(n) asm volatile("s_waitcnt lgkmcnt(" #n ")" ::: "memory")
#define PG8_BAR __builtin_amdgcn_s_barrier()
#define PG8_SCHED __builtin_amdgcn_sched_barrier(0)
    Unit cur, nxt; int ui = 0;
    if (!S.next(0, cur)) return;
    Acc acc;
#pragma unroll
    for (int a = 0; a < 2; ++a)
#pragma unroll
        for (int b = 0; b < 2; ++b)
#pragma unroll
            for (int m = 0; m < 4; ++m)
#pragma unroll
                for (int n = 0; n < 2; ++n) acc[a][b][m][n] = (f32x4){0.f, 0.f, 0.f, 0.f};
    bf16x8 At[4][2], B0[2][2], B1[2][2];
    const char* cA = g.abase(cur); const char* cB = g.bbase(cur); int nt = g.ntiles(cur);
    PG8_STAGE(PG8_SB(0, 0), cB, voffB); PG8_STAGE(PG8_SB(0, 1), cB + hstepB, voffB); PG8_STAGE(PG8_SA(0, 0), cA, voffA); PG8_STAGE(PG8_SA(0, 1), cA + hstepA, voffA);
    if (wr == 1) PG8_BAR;
    PG8_WAIT_V(2); PG8_BAR;
    PG8_STAGE(PG8_SB(1, 0), cB + kstep, voffB); PG8_STAGE(PG8_SA(1, 0), cA + kstep, voffA); PG8_STAGE(PG8_SB(1, 1), cB + hstepB + kstep, voffB);
    PG8_WAIT_V(6); PG8_BAR;
    for (;;) {
        const bool has_next = S.next(ui + 1, nxt);
        const char* nA = has_next ? g.abase(nxt) : cA; const char* nB = has_next ? g.bbase(nxt) : cB;
        for (int t = 0; t < nt; t += 2) {
            const bool last = (t == nt - 2);
            const char* a1 = cA + (size_t)(t + 1) * kstep;
            const char* a2 = last ? nA : cA + (size_t)(t + 2) * kstep; const char* b2 = last ? nB : cB + (size_t)(t + 2) * kstep;
            const char* a3 = a2 + kstep; const char* b3 = b2 + kstep;
            PG8_LDB(B0, 0, 0); PG8_LDB(B1, 0, 1); PG8_SCHED; PG8_LDA(At, 0, 0); PG8_STAGE(PG8_SA(1, 1), a1 + hstepA, voffA);
            PG8_WAIT_V(8); PG8_WAIT_L(0); PG8_BAR; PG8_MMA(0, 0, At, B0); PG8_MMA(0, 1, At, B1); PG8_BAR; PG8_SCHED;
            PG8_LDA(At, 0, 1); PG8_STAGE(PG8_SB(0, 0), b2, voffB); PG8_STAGE(PG8_SB(0, 1), b2 + hstepB, voffB); PG8_STAGE(PG8_SA(0, 0), a2, voffA);
            PG8_WAIT_V(8); PG8_WAIT_L(0); PG8_BAR; PG8_MMA(1, 0, At, B0); PG8_MMA(1, 1, At, B1); PG8_BAR; PG8_SCHED;
            PG8_LDB(B0, 1, 0); PG8_LDB(B1, 1, 1); PG8_SCHED; PG8_LDA(At, 1, 0); PG8_STAGE(PG8_SA(0, 1), a2 + hstepA, voffA);
            PG8_WAIT_V(8); PG8_WAIT_L(0); PG8_BAR; PG8_MMA(0, 0, At, B0); PG8_MMA(0, 1, At, B1); PG8_BAR; PG8_SCHED;
            PG8_LDA(At, 1, 1); PG8_STAGE(PG8_SB(1, 0), b3, voffB); PG8_STAGE(PG8_SB(1, 1), b3 + hstepB, voffB); PG8_STAGE(PG8_SA(1, 0), a3, voffA);
            PG8_WAIT_V(8); PG8_WAIT_L(0); PG8_BAR; PG8_MMA(1, 0, At, B0); PG8_MMA(1, 1, At, B1); PG8_BAR; PG8_SCHED;
        }
        if (wr == 0) PG8_BAR;
        E(acc, cur, wr, wc, fr, fq);
        if (!has_next) break;
        if (!E.keep(cur)) {
#pragma unroll
        for (int a = 0; a < 2; ++a)
#pragma unroll
            for (int b = 0; b < 2; ++b)
#pragma unroll
                for (int m = 0; m < 4; ++m)
#pragma unroll
                    for (int n = 0; n < 2; ++n) acc[a][b][m][n] = (f32x4){0.f, 0.f, 0.f, 0.f};
        }
        cur = nxt; cA = nA; cB = nB; nt = g.ntiles(cur); ++ui;
        if (wr == 1) PG8_BAR;
    }
    PG8_WAIT_V(0);
    PG8_BAR;
#undef PG8_SA
#undef PG8_SB
#undef PG8_STAGE
#undef PG8_LDA
#undef PG8_LDB
#undef PG8_MMA
#undef PG8_WAIT_V
#undef PG8_WAIT_L
#undef PG8_BAR
#undef PG8_SCHED
}

struct EpiStore {
    static constexpr bool PERM = true;
    __device__ __forceinline__ bool keep(const Unit&) const { return false; }
    bf16_t* O; int ldc;
    __device__ __forceinline__ void operator()(const Acc& acc, const Unit& u, int wr, int wc, int fr, int fq) const {
        const int row0 = u.pm * BM + wr * 64 + fr, col0 = u.pn * BM + wc * 32 + 8 * fq;
#pragma unroll
        for (int ai = 0; ai < 2; ++ai)
#pragma unroll
            for (int m = 0; m < 4; ++m) { bf16_t* rowp = O + (size_t)(row0 + ai * HALF + m * 16) * ldc + col0;
#pragma unroll
                for (int bj = 0; bj < 2; ++bj) { const f32x4 v0 = acc[ai][bj][m][0], v1 = acc[ai][bj][m][1];
                    u32x4 w; w.x = cvt_pk_bf16(v0[0], v0[1]); w.y = cvt_pk_bf16(v0[2], v0[3]); w.z = cvt_pk_bf16(v1[0], v1[1]); w.w = cvt_pk_bf16(v1[2], v1[3]);
                    *(u32x4*)(rowp + bj * HALF) = w; } }
    }
};
struct EpiZ {
    static constexpr bool PERM = true;
    __device__ __forceinline__ bool keep(const Unit&) const { return false; }
    bf16_t* Z; bf16_t* G; const float* bgate;
    __device__ __forceinline__ void operator()(const Acc& acc, const Unit& u, int wr, int wc, int fr, int fq) const {
        const int row0 = u.pm * BM + wr * 64 + fr;
        if (u.pn < 16) {
            const int col0 = u.pn * BM + wc * 32 + 8 * fq;
#pragma unroll
            for (int ai = 0; ai < 2; ++ai)
#pragma unroll
                for (int m = 0; m < 4; ++m) { bf16_t* rowp = Z + (size_t)(row0 + ai * HALF + m * 16) * 4096 + col0;
#pragma unroll
                    for (int bj = 0; bj < 2; ++bj) { const f32x4 v0 = acc[ai][bj][m][0], v1 = acc[ai][bj][m][1];
                        u32x4 w; w.x = cvt_pk_bf16(v0[0], v0[1]); w.y = cvt_pk_bf16(v0[2], v0[3]); w.z = cvt_pk_bf16(v1[0], v1[1]); w.w = cvt_pk_bf16(v1[2], v1[3]);
                        *(u32x4*)(rowp + bj * HALF) = w; } }
        } else {
            const int col0 = (u.pn - 16) * BM + wc * 32 + 8 * fq;
            f32x4 bv[2][2];
#pragma unroll
            for (int bj = 0; bj < 2; ++bj)
#pragma unroll
                for (int n = 0; n < 2; ++n) bv[bj][n] = *(const f32x4*)(bgate + col0 + bj * HALF + 4 * n) * (-1.44269504f);
            unsigned char* Gq = (unsigned char*)G + ((size_t)(u.pm * 4 + ((u.pn - 16) >> 3)) * 8 + ((u.pn - 16) & 7)) * 65536 + (size_t)(wr * 4 + wc) * 8192 + (size_t)(fq * 16 + fr) * 16;
#pragma unroll
            for (int ai = 0; ai < 2; ++ai)
#pragma unroll
                for (int m = 0; m < 4; ++m) {
                    unsigned wv[4] = {0u, 0u, 0u, 0u};
#pragma unroll
                    for (int bj = 0; bj < 2; ++bj)
#pragma unroll
                        for (int n = 0; n < 2; ++n) { const f32x4 a4 = acc[ai][bj][m][n], b4 = bv[bj][n];
#pragma unroll
                            for (int j = 0; j < 4; ++j) {
                                const float e = __builtin_amdgcn_exp2f(__builtin_fmaf(a4[j], -1.44269504f, b4[j]));
                                wv[bj * 2 + n] = __builtin_amdgcn_cvt_pk_u8_f32(fmaxf(__builtin_amdgcn_rcpf(__builtin_fmaf(e, 1.0f / 255.0f, 1.0f / 255.0f)), 1.0f), j, wv[bj * 2 + n]); } }
                    u32x4 w; w.x = wv[0]; w.y = wv[1]; w.z = wv[2]; w.w = wv[3];
                    *(u32x4*)(Gq + (ai * 4 + m) * 1024) = w; }
        }
    }
};
struct EpiSwiglu {
    static constexpr bool PERM = true;
    __device__ __forceinline__ bool keep(const Unit&) const { return false; }
    bf16_t* O;
    __device__ __forceinline__ void operator()(const Acc& acc, const Unit& u, int wr, int wc, int fr, int fq) const {
        const int row0 = u.pm * BM + wr * 64 + fr, col0 = u.pn * HALF + wc * 32 + 8 * fq;
#pragma unroll
        for (int ai = 0; ai < 2; ++ai)
#pragma unroll
            for (int m = 0; m < 4; ++m) { bf16_t* rowp = O + (size_t)(row0 + ai * HALF + m * 16) * DFF + col0;
                f32x4 v0, v1;
#pragma unroll
                for (int j = 0; j < 4; ++j) { const float g0 = acc[ai][0][m][0][j], g1 = acc[ai][0][m][1][j];
                    v0[j] = g0 * sigmoidf_(g0) * acc[ai][1][m][0][j]; v1[j] = g1 * sigmoidf_(g1) * acc[ai][1][m][1][j]; }
                u32x4 w; w.x = cvt_pk_bf16(v0[0], v0[1]); w.y = cvt_pk_bf16(v0[2], v0[3]); w.z = cvt_pk_bf16(v1[0], v1[1]); w.w = cvt_pk_bf16(v1[2], v1[3]);
                *(u32x4*)rowp = w; }
    }
};
struct EpiResid {
    static constexpr bool PERM = true;
    __device__ __forceinline__ bool keep(const Unit&) const { return false; }
    const float* xin_ctx; const float* xin_lat; bf16_t* xb; float* yout; const float* modl; int gidx; int grow0;
    __device__ __forceinline__ void operator()(const Acc& acc, const Unit& u, int wr, int wc, int fr, int fq) const {
        const int prow = grow0 + u.pm * BM;
        const int cond = prow < TCTX ? 0 : 1 + ((prow - TCTX) >> 12);
        const float* gv = modl + (size_t)cond * 12288 + gidx * DM;
        const int rl0 = wr * 64 + fr, col0 = u.pn * BM + wc * 32 + 8 * fq;
        f32x4 g4[2][2];
#pragma unroll
        for (int bj = 0; bj < 2; ++bj)
#pragma unroll
            for (int n = 0; n < 2; ++n) g4[bj][n] = *(const f32x4*)(gv + col0 + bj * HALF + n * 4);
        bf16_t* xo = xb + (size_t)prow * DM;
        if (xin_ctx) {
            const float* xin = prow < TCTX ? xin_ctx + (size_t)prow * DM : xin_lat + (size_t)(prow - TCTX) * DM;
#pragma unroll
            for (int ai = 0; ai < 2; ++ai) {
#pragma unroll
                for (int m = 0; m < 4; ++m) { const size_t off = (size_t)(rl0 + ai * HALF + m * 16) * DM + col0;
#pragma unroll
                    for (int bj = 0; bj < 2; ++bj) { const f32x4 x0 = *(const f32x4*)(xin + off + bj * HALF), x1 = *(const f32x4*)(xin + off + bj * HALF + 4);
                        const f32x4 r0 = x0 + g4[bj][0] * acc[ai][bj][m][0], r1 = x1 + g4[bj][1] * acc[ai][bj][m][1];
                        u32x4 w; w.x = cvt_pk_bf16(r0[0], r0[1]); w.y = cvt_pk_bf16(r0[2], r0[3]); w.z = cvt_pk_bf16(r1[0], r1[1]); w.w = cvt_pk_bf16(r1[2], r1[3]);
                        *(u32x4*)(xo + off + bj * HALF) = w; } }
                asm volatile("" ::: "memory"); }
        } else {
            u32x4 xw[4][2];
#pragma unroll
            for (int m = 0; m < 4; ++m)
#pragma unroll
                for (int bj = 0; bj < 2; ++bj) xw[m][bj] = *(const u32x4*)(xo + (size_t)(rl0 + m * 16) * DM + col0 + bj * HALF);
            float* yo = yout ? yout + (size_t)prow * DM : nullptr;
#pragma unroll
            for (int ai = 0; ai < 2; ++ai) {
#pragma unroll
                for (int m = 0; m < 4; ++m) { const size_t off = (size_t)(rl0 + ai * HALF + m * 16) * DM + col0;
#pragma unroll
                    for (int bj = 0; bj < 2; ++bj) { const u32x4 w4 = xw[m][bj];
                        if (ai == 0) xw[m][bj] = *(const u32x4*)(xo + off + (size_t)HALF * DM + bj * HALF);
                        const f32x4 x0 = {bf_lo(w4.x), bf_hi(w4.x), bf_lo(w4.y), bf_hi(w4.y)}, x1 = {bf_lo(w4.z), bf_hi(w4.z), bf_lo(w4.w), bf_hi(w4.w)};
                        const f32x4 r0 = x0 + g4[bj][0] * acc[ai][bj][m][0], r1 = x1 + g4[bj][1] * acc[ai][bj][m][1];
                        if (yo) { *(f32x4*)(yo + off + bj * HALF) = r0; *(f32x4*)(yo + off + bj * HALF + 4) = r1; }
                        else { u32x4 w; w.x = cvt_pk_bf16(r0[0], r0[1]); w.y = cvt_pk_bf16(r0[2], r0[3]); w.z = cvt_pk_bf16(r1[0], r1[1]); w.w = cvt_pk_bf16(r1[2], r1[3]);
                            *(u32x4*)(xo + off + bj * HALF) = w; } } } }
        }
    }
};
struct EpiMerge {
    static constexpr bool PERM = true;
    const unsigned char* G; bf16_t* Mo;
    __device__ __forceinline__ bool keep(const Unit& u) const { return u.seg != 3; }
    __device__ __forceinline__ void operator()(Acc& acc, const Unit& u, int wr, int wc, int fr, int fq) const {
        const int seg = u.seg;
        const int urow = u.pm * BM + wr * 64, ucol = u.pn * BM + wc * 32;
        const char* gbase = (const char*)(G + ((size_t)(u.pm * 4 + seg) * 8 + u.pn) * 65536 + (size_t)(wr * 4 + wc) * 8192);
        char* mbase = (char*)(Mo + (size_t)urow * DM + ucol);
        unsigned goff = (unsigned)(fq * 16 + fr) * 16u, moff = (unsigned)(fr * DM + 8 * fq) * 2u;
        asm volatile("" : "+v"(goff), "+v"(moff));
        u32x4 gw[8], hw[8];
#pragma unroll
        for (int q = 0; q < 8; ++q) { gw[q] = *(const u32x4*)(gbase + q * 1024 + goff);
            if (seg != 3) hw[q] = *(const u32x4*)(gbase + 8 * 65536 + q * 1024 + goff); else hw[q] = (u32x4){0u, 0u, 0u, 0u}; }
#pragma unroll
        for (int ai = 0; ai < 2; ++ai) {
#pragma unroll
            for (int m = 0; m < 4; ++m) {
                const u32x4 g4 = gw[ai * 4 + m], h4 = hw[ai * 4 + m];
                const unsigned gq[4] = {g4.x, g4.y, g4.z, g4.w}, hq[4] = {h4.x, h4.y, h4.z, h4.w};
#pragma unroll
                for (int bj = 0; bj < 2; ++bj) {
                    float f[8];
#pragma unroll
                    for (int n = 0; n < 2; ++n) { const unsigned gx = gq[bj * 2 + n], hx = hq[bj * 2 + n];
                        f[4 * n + 0] = (float)(gx & 255u); f[4 * n + 1] = (float)((gx >> 8) & 255u); f[4 * n + 2] = (float)((gx >> 16) & 255u); f[4 * n + 3] = (float)(gx >> 24);
                        if (seg != 3) { f[4 * n + 0] *= __builtin_amdgcn_rcpf((float)(hx & 255u)); f[4 * n + 1] *= __builtin_amdgcn_rcpf((float)((hx >> 8) & 255u));
                            f[4 * n + 2] *= __builtin_amdgcn_rcpf((float)((hx >> 16) & 255u)); f[4 * n + 3] *= __builtin_amdgcn_rcpf((float)(hx >> 24)); }
                        else { f[4 * n + 0] *= (1.0f / 255.0f); f[4 * n + 1] *= (1.0f / 255.0f); f[4 * n + 2] *= (1.0f / 255.0f); f[4 * n + 3] *= (1.0f / 255.0f); } }
                    f32x4 v0 = acc[ai][bj][m][0], v1 = acc[ai][bj][m][1];
                    v0[0] *= f[0]; v0[1] *= f[1]; v0[2] *= f[2]; v0[3] *= f[3]; v1[0] *= f[4]; v1[1] *= f[5]; v1[2] *= f[6]; v1[3] *= f[7];
                    if (seg != 3) { acc[ai][bj][m][0] = v0; acc[ai][bj][m][1] = v1; }
                    else { u32x4 w; w.x = cvt_pk_bf16(v0[0], v0[1]); w.y = cvt_pk_bf16(v0[2], v0[3]); w.z = cvt_pk_bf16(v1[0], v1[1]); w.w = cvt_pk_bf16(v1[2], v1[3]);
                        *(u32x4*)(mbase + (size_t)(ai * HALF + m * 16) * (DM * 2) + bj * 256 + moff) = w; } } }
            asm volatile("" ::: "memory"); }
    }
};
}

struct Args { const float* in[31]; float* out; unsigned char* ws; int step_lo, step_hi; };
enum { I_XP = 0, I_XS, I_CCKV, I_CKPE, I_C, I_CCTX, I_WMOD, I_BMOD, I_NMIX, I_NFFN, I_WIN, I_BGATE, I_QAN, I_KVAN, I_WUQ, I_WUKV, I_QN, I_KN,
       I_WPOOL, I_PSCALE, I_SGUN, I_WSP, I_BSP, I_CONVW, I_WBA, I_WBP, I_WBS, I_WBC, I_WOUT, I_WFI, I_WFO };

struct Grp { int row0, rows, nseq, L, C, tkv; };
__device__ __forceinline__ Grp grp_of(int g) {
    Grp r;
    if (g == 0) { r.row0 = 0; r.rows = 4096; r.nseq = 16; r.L = 256; r.C = 0; r.tkv = 4096; }
    else { r.row0 = TCTX + (g - 1) * 16384; r.rows = 16384; r.nseq = 4; r.L = 4096; r.C = 256; r.tkv = 17408; }
    return r;
}

struct Frame {
    LAS unsigned char* lds;
    int tid, lane, wave, bx, G, gw, ngw;
    const float* const* in; float* out; unsigned char* ws;
};

__device__ __forceinline__ Frame fresh(const Frame& F0) {
    Frame F = F0;
    asm volatile("" : "+v"(F.tid));
    int z; asm volatile("s_mov_b32 %0, 0" : "=s"(z));
    F.in = F0.in + z; F.out = F0.out + z; F.ws = F0.ws + z; F.bx = F0.bx + z;
    F.lane = F.tid & 63; F.wave = __builtin_amdgcn_readfirstlane(F.tid >> 6);
    F.gw = F.bx * NWAVE + F.wave; F.ngw = F.G * NWAVE;
    return F;
}
#define LAUNDER_S(x) do { int z_; asm volatile("s_mov_b32 %0, 0" : "=s"(z_)); (x) += z_; } while (0)
struct TrDesc { const float* W; const float* ks; bf16_t* dst; int ldw, k0, n0, ldd; };
__device__ __forceinline__ void tr_load(const TrDesc& d, f32x4 (&tv)[8], int lane) {
#pragma unroll
    for (int i = 0; i < 8; ++i) tv[i] = *(const f32x4*)(d.W + (size_t)(d.k0 + 8 * i + (lane >> 3)) * d.ldw + d.n0 + 4 * (lane & 7));
}
__device__ __forceinline__ void tr_finish(const TrDesc& d, const f32x4 (&tv)[8], LAS float* scr, int lane) {
#pragma unroll
    for (int i = 0; i < 8; ++i) { const int kk = 8 * i + (lane >> 3); f32x4 v = tv[i]; if (d.ks) v = v * d.ks[d.k0 + kk];
        LAS float* q = scr + kk * 33 + 4 * (lane & 7); q[0] = v[0]; q[1] = v[1]; q[2] = v[2]; q[3] = v[3]; }
    LDS_WAIT(); asm volatile("" ::: "memory");
    const int c = lane & 7;
#pragma unroll
    for (int j = 0; j < 4; ++j) { const int n = (lane >> 3) + 8 * j; const LAS float* s = scr + (8 * c) * 33 + n;
        u32x4 o; o.x = cvt_pk_bf16(s[0 * 33], s[1 * 33]); o.y = cvt_pk_bf16(s[2 * 33], s[3 * 33]); o.z = cvt_pk_bf16(s[4 * 33], s[5 * 33]); o.w = cvt_pk_bf16(s[6 * 33], s[7 * 33]);
        *(u32x4*)(d.dst + (size_t)n * d.ldd + d.k0 + 8 * c) = o; }
    LDS_WAIT(); asm volatile("" ::: "memory");
}
__device__ __forceinline__ TrDesc tr_desc(int r, int l, const float* const* in, unsigned char* wl) {
    constexpr int IA = 32 * 385, IB = 12 * 48, IC = 4 * 64, ID = 16 * 64, IE = 8 * 64, IF_ = 8 * 64, IG = 32 * 64, IH = 32 * 352;
    TrDesc d; d.ks = nullptr;
    if (r < IA) { const int kb = r / 385, sg = r % 385; d.W = in[I_WIN] + (size_t)l * DM * NINW; d.ldw = NINW; d.k0 = 64 * kb; d.n0 = 32 * sg; d.ldd = 2048;
        d.dst = sg < 32 ? (bf16_t*)(wl + OFF_WIN) + (size_t)(32 * sg) * 2048 : sg == 32 ? (bf16_t*)(wl + OFF_WKPE) : (bf16_t*)(wl + OFF_WIN) + (size_t)(32 * (sg - 1)) * 2048; return d; } r -= IA;
    if (r < IB) { const int kb = r / 48, sg = r % 48; d.W = in[I_WUQ] + (size_t)l * QLORA * 1536; d.ldw = 1536; d.k0 = 64 * kb; d.n0 = 32 * sg; d.ldd = 768; d.ks = in[I_QAN] + l * QLORA;
        d.dst = (bf16_t*)(wl + OFF_WUQ) + (size_t)(32 * sg) * 768; return d; } r -= IB;
    if (r < IC) { const int kb = r / 64, sg = r % 64, hh = sg >> 2, part = sg & 3; d.W = in[I_WUKV] + (size_t)l * KVL * 2048; d.ldw = 2048; d.k0 = 64 * kb; d.n0 = 32 * sg; d.ldd = 256;
        d.dst = part < 2 ? (bf16_t*)(wl + OFF_WUK) + (size_t)(hh * 64 + 32 * part) * 256 : (bf16_t*)(wl + OFF_WUV) + (size_t)(hh * 64 + 32 * (part - 2)) * 256; return d; } r -= IC;
    if (r < ID) { const int kb = r / 64, sg = r % 64; d.W = in[I_WBA] + (size_t)l * 1024 * DM; d.ldw = DM; d.k0 = 64 * kb; d.n0 = 32 * sg; d.ldd = 2560; d.dst = (bf16_t*)(wl + OFF_WBR) + (size_t)(32 * sg) * 2560; return d; } r -= ID;
    if (r < IE) { const int kb = r / 64, sg = r % 64; d.W = in[I_WBS] + (size_t)l * 512 * DM; d.ldw = DM; d.k0 = 64 * kb; d.n0 = 32 * sg; d.ldd = 2560; d.dst = (bf16_t*)(wl + OFF_WBR) + (size_t)(32 * sg) * 2560 + 1536; return d; } r -= IE;
    if (r < IF_) { const int kb = r / 64, sg = r % 64; d.W = in[I_WBC] + (size_t)l * 512 * DM; d.ldw = DM; d.k0 = 64 * kb; d.n0 = 32 * sg; d.ldd = 2560; d.dst = (bf16_t*)(wl + OFF_WBR) + (size_t)(32 * sg) * 2560 + 2048; return d; } r -= IF_;
    if (r < IG) { const int kb = r / 64, sg = r % 64; d.W = in[I_WOUT] + (size_t)l * DM * DM; d.ldw = DM; d.k0 = 64 * kb; d.n0 = 32 * sg; d.ldd = 2048; d.dst = (bf16_t*)(wl + OFF_WOUT) + (size_t)(32 * sg) * 2048; return d; } r -= IG;
    if (r < IH) { const int kb = r / 352, sg = r % 352; const int s2 = sg < 176 ? sg : sg - 176; const int drow = 256 * (s2 >> 2) + 32 * (s2 & 3) + (sg < 176 ? 0 : 128);
        d.W = in[I_WFI] + (size_t)l * DM * 2 * DFF; d.ldw = 2 * DFF; d.k0 = 64 * kb; d.n0 = 32 * sg; d.ldd = 2048; d.dst = (bf16_t*)(wl + OFF_WFI) + (size_t)drow * 2048; return d; } r -= IH;
    { const int kb = r / 64, sg = r % 64; d.W = in[I_WFO] + (size_t)l * DFF * DM; d.ldw = DM; d.k0 = 64 * kb; d.n0 = 32 * sg; d.ldd = DFF; d.dst = (bf16_t*)(wl + OFF_WFO) + (size_t)(32 * sg) * DFF; return d; }
}
__device__ __forceinline__ void p0_prologue(Frame& F, int lcv) {
    if (lcv == 0)
    {
        LAS float* sc = (LAS float*)F.lds;
        LAS float* red = (LAS float*)(F.lds + 81920);
        for (int idx = F.tid; idx < NCOND * DM; idx += NTHR) { const int ci = idx >> 11, k = idx & 2047;
            const float v = ci == 0 ? F.in[I_CCTX][k] : F.in[I_C][(ci - 1) * DM + k];
            sc[k * 10 + ci] = v * sigmoidf_(v); }
        __syncthreads();
        for (int it = F.bx; it < NLAYER * 96; it += F.G) {
            const int l = it / 96, jb = it % 96, col = jb * 128 + 2 * F.lane;
            const float* wp = F.in[I_WMOD] + (size_t)l * DM * 12288 + col;
            float a[9][2];
#pragma unroll
            for (int i = 0; i < 9; ++i) { a[i][0] = 0.f; a[i][1] = 0.f; }
            const int kb = F.wave * 256;
#pragma unroll 16
            for (int k = kb; k < kb + 256; ++k) { const f32x2 wv = *(const f32x2*)(wp + (size_t)k * 12288);
                const LAS f32x2* s2 = (const LAS f32x2*)(sc + k * 10);
                const f32x2 s0 = s2[0], s1 = s2[1], s2_ = s2[2], s3 = s2[3], s4 = s2[4];
                a[0][0] += wv.x * s0.x; a[0][1] += wv.y * s0.x; a[1][0] += wv.x * s0.y; a[1][1] += wv.y * s0.y;
                a[2][0] += wv.x * s1.x; a[2][1] += wv.y * s1.x; a[3][0] += wv.x * s1.y; a[3][1] += wv.y * s1.y;
                a[4][0] += wv.x * s2_.x; a[4][1] += wv.y * s2_.x; a[5][0] += wv.x * s2_.y; a[5][1] += wv.y * s2_.y;
                a[6][0] += wv.x * s3.x; a[6][1] += wv.y * s3.x; a[7][0] += wv.x * s3.y; a[7][1] += wv.y * s3.y;
                a[8][0] += wv.x * s4.x; a[8][1] += wv.y * s4.x; }
#pragma unroll
            for (int i = 0; i < 9; ++i) *(LAS f32x2*)(red + (F.wave * 9 + i) * 128 + 2 * F.lane) = (f32x2){a[i][0], a[i][1]};
            __syncthreads();
            for (int o = F.tid; o < 1152; o += NTHR) { const int i = o >> 7, ln = o & 127; float s = 0.f;
#pragma unroll
                for (int w = 0; w < 8; ++w) s += red[(w * 9 + i) * 128 + ln];
                const int c2 = jb * 128 + ln;
                ((float*)(F.ws + WS_MOD))[((size_t)l * NCOND + i) * 12288 + c2] = s + F.in[I_BMOD][(size_t)l * 12288 + c2]; }
            __syncthreads();
        }
    }
    __syncthreads();
    {
        LAS float* scr = (LAS float*)(F.lds + F.wave * 16384);
        constexpr int NIT = 32 * 385 + 12 * 48 + 4 * 64 + 16 * 64 + 8 * 64 + 8 * 64 + 32 * 64 + 32 * 352 + 88 * 64;
        unsigned char* wl = F.ws + WS_W0;
        int it = F.gw;
        TrDesc cur; f32x4 tv[8];
        if (it < NIT) { cur = tr_desc(it, lcv, F.in, wl); tr_load(cur, tv, F.lane); }
        for (; it < NIT; it += F.ngw) {
            TrDesc nxt = cur; f32x4 tn[8];
            const bool hn = it + F.ngw < NIT;
            if (hn) { nxt = tr_desc(it + F.ngw, lcv, F.in, wl); tr_load(nxt, tn, F.lane); }
            tr_finish(cur, tv, scr, F.lane);
            if (hn) {
#pragma unroll
                for (int i = 0; i < 8; ++i) tv[i] = tn[i];
                cur = nxt; }
        }
    }
    {
        int ngt = F.G * NTHR; LAUNDER_S(ngt);
        const int gt = F.bx * NTHR + F.tid;
        for (int e = gt; e < 65536; e += ngt) { const int l = lcv;
            ((bf16_t*)(F.ws + WS_W0 + OFF_WSP))[e] = (bf16_t)(cvt_pk_bf16(F.in[I_WSP][l * 65536 + e], 0.f) & 0xffffu); }
    }
    {
        LAS float* Al = (LAS float*)F.lds;
        LAS float* Bl = (LAS float*)(F.lds + 65536);
        for (int it = F.bx; it < 4 * 32; it += F.G) {
            const int l = lcv, g = (it >> 5) & 3, nb = it & 31;
            const float* wp = F.in[I_WPOOL] + (size_t)(l * 4 + g) * 128 * 128;
            const float* ps = F.in[I_PSCALE] + l * 512 + g * 128;
            const float* wb = F.in[I_WBP] + ((size_t)l * 512 + g * 128) * DM + nb * 64;
            __syncthreads();
#pragma unroll
            for (int q = 0; q < 8; ++q) { const int i4 = F.tid + NTHR * q, k = i4 >> 5, j4 = (i4 & 31) * 4;
                *(LAS f32x4*)(Al + k * 128 + j4) = *(const f32x4*)(wp + k * 128 + j4) * *(const f32x4*)(ps + j4); }
#pragma unroll
            for (int q = 0; q < 4; ++q) { const int i4 = F.tid + NTHR * q, j = i4 >> 4, n4 = (i4 & 15) * 4;
                *(LAS f32x4*)(Bl + j * 64 + n4) = *(const f32x4*)(wb + (size_t)j * DM + n4); }
            __syncthreads();
            const int n = F.tid & 63, k0 = (F.tid >> 6) * 16;
            float acc[16];
#pragma unroll
            for (int kk = 0; kk < 16; ++kk) acc[kk] = 0.f;
            for (int j4 = 0; j4 < 32; ++j4) {
                const float b0 = Bl[(4 * j4 + 0) * 64 + n], b1 = Bl[(4 * j4 + 1) * 64 + n], b2 = Bl[(4 * j4 + 2) * 64 + n], b3 = Bl[(4 * j4 + 3) * 64 + n];
#pragma unroll
                for (int kk = 0; kk < 16; ++kk) { const f32x4 a4 = *(const LAS f32x4*)(Al + (k0 + kk) * 128 + 4 * j4); acc[kk] += (a4[0] * b0 + a4[1] * b1) + (a4[2] * b2 + a4[3] * b3); } }
            bf16_t* dst = (bf16_t*)(F.ws + WS_W0 + OFF_WBR) + (size_t)(nb * 64 + n) * 2560 + 1024 + g * 128 + k0;
            float o0[8], o1[8];
#pragma unroll
            for (int kk = 0; kk < 8; ++kk) { o0[kk] = acc[kk]; o1[kk] = acc[8 + kk]; }
            store8(dst, o0); store8(dst + 8, o1);
        }
        __syncthreads();
    }
}

template <bool KPE, bool XBF>
__device__ __forceinline__ void thin_norm(Frame& F, int l, const float* xc, const float* xl, const float* nw, int ish, int isc) {
    constexpr int HL = 4112;
    LAS unsigned char* hl = F.lds; LAS float* red = (LAS float*)(F.lds + 66048);
    const float* modl = (const float*)(F.ws + WS_MOD) + (size_t)l * NCOND * 12288;
    bf16_t* H = (bf16_t*)(F.ws + WS_H);
    const bf16_t* XB = (const bf16_t*)(F.ws + WS_XB);
    const bf16_t* WK = (const bf16_t*)(F.ws + WS_W0 + OFF_WKPE);
    bf16_t* KP = (bf16_t*)(F.ws + WS_KPE);
    const int nitems = TALL / 16, per = (nitems + F.G - 1) / F.G, it_lo = F.bx * per, it_hi = (it_lo + per < nitems) ? it_lo + per : nitems;
    f32x4 A[8], B[8]; int cond_cur = -1;
    f32x4 vn[8]; u32x4 vb[4];
#define TN_LOAD(row_) do { if (XBF) { const bf16_t* xr_ = XB + (size_t)(row_) * DM + 8 * F.lane; \
            _Pragma("unroll") for (int j = 0; j < 4; ++j) vb[j] = *(const u32x4*)(xr_ + 512 * j); } \
        else { const float* xr_ = ((row_) < TCTX ? xc + (size_t)(row_) * DM : xl + (size_t)((row_) - TCTX) * DM) + 8 * F.lane; \
            _Pragma("unroll") for (int j = 0; j < 4; ++j) { vn[2 * j] = *(const f32x4*)(xr_ + 512 * j); vn[2 * j + 1] = *(const f32x4*)(xr_ + 512 * j + 4); } } } while (0)
    if (it_lo < it_hi) TN_LOAD(it_lo * 16 + 2 * F.wave);
    for (int it = it_lo; it < it_hi; ++it) {
        const int prow = it * 16;
        const int cond = prow < TCTX ? 0 : 1 + ((prow - TCTX) >> 12);
        if (cond != cond_cur) { cond_cur = cond;
            const float* sh = modl + (size_t)cond * 12288 + ish * DM; const float* sc = modl + (size_t)cond * 12288 + isc * DM;
#pragma unroll
            for (int j = 0; j < 8; ++j) { const int c = 8 * F.lane + 512 * (j >> 1) + 4 * (j & 1); const f32x4 w4 = *(const f32x4*)(nw + c), s4 = *(const f32x4*)(sc + c); A[j] = w4 * (1.0f + s4); B[j] = *(const f32x4*)(sh + c); } }
#pragma unroll
        for (int rr = 0; rr < 2; ++rr) {
            const int rl = 2 * F.wave + rr, row = prow + rl; float ss = 0.f;
            f32x4 v[8];
            if (XBF) {
#pragma unroll
                for (int j = 0; j < 4; ++j) { const u32x4 w = vb[j]; v[2 * j] = (f32x4){bf_lo(w.x), bf_hi(w.x), bf_lo(w.y), bf_hi(w.y)}; v[2 * j + 1] = (f32x4){bf_lo(w.z), bf_hi(w.z), bf_lo(w.w), bf_hi(w.w)}; }
            } else {
#pragma unroll
                for (int j = 0; j < 8; ++j) v[j] = vn[j];
            }
            if (rr == 0) TN_LOAD(row + 1); else if (it + 1 < it_hi) TN_LOAD(row + 15);
#pragma unroll
            for (int j = 0; j < 8; ++j) ss += (v[j][0] * v[j][0] + v[j][1] * v[j][1]) + (v[j][2] * v[j][2] + v[j][3] * v[j][3]);
            const float rstd = rsqrtf(wave_sum(ss) * (1.0f / DM) + EPS);
#pragma unroll
            for (int j = 0; j < 4; ++j) { const f32x4 h0 = v[2 * j] * rstd * A[2 * j] + B[2 * j], h1 = v[2 * j + 1] * rstd * A[2 * j + 1] + B[2 * j + 1];
                u32x4 w; w.x = cvt_pk_bf16(h0[0], h0[1]); w.y = cvt_pk_bf16(h0[2], h0[3]); w.z = cvt_pk_bf16(h1[0], h1[1]); w.w = cvt_pk_bf16(h1[2], h1[3]);
                *(u32x4*)(H + (size_t)row * DM + 8 * F.lane + 512 * j) = w;
                if (KPE) *(LAS u32x4*)(hl + rl * HL + (8 * F.lane + 512 * j) * 2) = w; }
        }
        if (KPE) {
            __syncthreads();
            const int fr = F.lane & 15, fq = F.lane >> 4;
            f32x4 a0 = {0.f, 0.f, 0.f, 0.f}, a1 = {0.f, 0.f, 0.f, 0.f};
#pragma unroll
            for (int ks = 0; ks < 8; ++ks) { const int k = 256 * F.wave + 32 * ks + 8 * fq;
                const bf16x8 af = *(const LAS bf16x8*)(hl + fr * HL + k * 2);
                const bf16x8 b0 = *(const bf16x8*)(WK + (size_t)fr * DM + k), b1 = *(const bf16x8*)(WK + (size_t)(16 + fr) * DM + k);
                a0 = __builtin_amdgcn_mfma_f32_16x16x32_bf16(b0, af, a0, 0, 0, 0); a1 = __builtin_amdgcn_mfma_f32_16x16x32_bf16(b1, af, a1, 0, 0, 0); }
            *(LAS f32x4*)(red + F.wave * 512 + fr * 32 + 4 * fq) = a0; *(LAS f32x4*)(red + F.wave * 512 + fr * 32 + 16 + 4 * fq) = a1;
            __syncthreads();
            { const int rl = F.tid >> 5, n = F.tid & 31; float s = 0.f;
#pragma unroll
                for (int w = 0; w < 8; ++w) s += red[w * 512 + rl * 32 + n];
                const int row = prow + rl;
                KP[(size_t)row * 32 + n] = (bf16_t)(cvt_pk_bf16(s, 0.f) & 0xffffu);
                if (row < TCTX) { const int b = row >> 8, sidx = row & 255; F.out[(size_t)TALL * DM + (size_t)16 * 2 * 256 * 256 + ((size_t)(b * 2 + l) * 256 + sidx) * 32 + n] = s; } }
            __syncthreads();
        }
    }
#undef TN_LOAD
}

__device__ __forceinline__ void thin_b(Frame& F, int l, int g) {
    const Grp gr = grp_of(g);
    unsigned char* gb = F.ws + WS_G;
    const bf16_t* Z = (const bf16_t*)(gb + G_Z); bf16_t* CKV = (bf16_t*)(gb + G_CKV); bf16_t* BR = (bf16_t*)(gb + G_BR);
    const float* kvan = F.in[I_KVAN] + l * KVL; const float* convw = F.in[I_CONVW] + l * 3 * 512;
    const int lane = F.lane;
    for (int r = gr.rows + F.gw; r < gr.tkv; r += F.ngw) {
        const int ci = r - gr.rows, sq = ci >> 8, p = ci & 255, b = 4 * (g - 1) + sq;
        const f32x4 v = *(const f32x4*)(F.in[I_CCKV] + (((size_t)b * 2 + l) * 256 + p) * 256 + 4 * lane);
        u32x2 w; w.x = cvt_pk_bf16(v[0], v[1]); w.y = cvt_pk_bf16(v[2], v[3]); *(u32x2*)(CKV + (size_t)r * 256 + 4 * lane) = w;
    }
    for (int ch = F.gw; ch < (gr.rows >> 2); ch += F.ngw) {
        const int r0 = ch * 4, pos0 = r0 % gr.L;
        const bf16_t* z0 = Z + (size_t)r0 * 4096;
        const int c0 = 8 * lane;
        u32x2 cw[4];
#pragma unroll
        for (int i = 0; i < 4; ++i) cw[i] = *(const u32x2*)(z0 + (size_t)i * 4096 + 768 + 4 * lane);
        u32x4 bgw[4], cgw[6], xcw[6];
#pragma unroll
        for (int i = 0; i < 4; ++i) bgw[i] = *(const u32x4*)(z0 + (size_t)i * 4096 + 2560 + c0);
#pragma unroll
        for (int j = 0; j < 6; ++j) { const int pr = pos0 - 1 + j; const bool ok = pr >= 0 && pr < gr.L;
            cgw[j] = ok ? *(const u32x4*)(z0 + (ptrdiff_t)(j - 1) * 4096 + 3072 + c0) : (u32x4){0u, 0u, 0u, 0u};
            xcw[j] = ok ? *(const u32x4*)(z0 + (ptrdiff_t)(j - 1) * 4096 + 3584 + c0) : (u32x4){0u, 0u, 0u, 0u}; }
        const int wh = 1 << (lane >> 4);
        u32x4 pw_[19];
#pragma unroll
        for (int j = 0; j < 19; ++j) { const int d = j - 8, pr = pos0 + d; const bool ok = pr >= 0 && pr < gr.L && d >= -wh && d <= wh + 2;
            pw_[j] = ok ? *(const u32x4*)(z0 + (ptrdiff_t)d * 4096 + 1024 + c0) : (u32x4){0u, 0u, 0u, 0u}; }
        { const f32x4 kw4 = *(const f32x4*)(kvan + 4 * lane);
#pragma unroll
          for (int i = 0; i < 4; ++i) { f32x4 v = {bf_lo(cw[i].x), bf_hi(cw[i].x), bf_lo(cw[i].y), bf_hi(cw[i].y)};
            const float ss = wave_sum((v[0] * v[0] + v[1] * v[1]) + (v[2] * v[2] + v[3] * v[3]));
            v = v * rsqrtf(ss * (1.0f / KVL) + EPS) * kw4;
            u32x2 o; o.x = cvt_pk_bf16(v[0], v[1]); o.y = cvt_pk_bf16(v[2], v[3]); *(u32x2*)(CKV + (size_t)(r0 + i) * 256 + 4 * lane) = o;
            if (g == 0) { const int rr = r0 + i, b = rr >> 8, sidx = rr & 255; *(f32x4*)(F.out + (size_t)TALL * DM + ((size_t)(b * 2 + l) * 256 + sidx) * 256 + 4 * lane) = v; } } }
        { float y[6][8];
#pragma unroll
          for (int j = 0; j < 6; ++j) { y[j][0] = bf_lo(cgw[j].x) * bf_lo(xcw[j].x); y[j][1] = bf_hi(cgw[j].x) * bf_hi(xcw[j].x); y[j][2] = bf_lo(cgw[j].y) * bf_lo(xcw[j].y); y[j][3] = bf_hi(cgw[j].y) * bf_hi(xcw[j].y);
              y[j][4] = bf_lo(cgw[j].z) * bf_lo(xcw[j].z); y[j][5] = bf_hi(cgw[j].z) * bf_hi(xcw[j].z); y[j][6] = bf_lo(cgw[j].w) * bf_lo(xcw[j].w); y[j][7] = bf_hi(cgw[j].w) * bf_hi(xcw[j].w); }
          float k0[8], k1[8], k2[8];
#pragma unroll
          for (int q = 0; q < 8; ++q) { k0[q] = convw[c0 + q]; k1[q] = convw[512 + c0 + q]; k2[q] = convw[1024 + c0 + q]; }
#pragma unroll
          for (int i = 0; i < 4; ++i) { const float bgv[8] = {bf_lo(bgw[i].x), bf_hi(bgw[i].x), bf_lo(bgw[i].y), bf_hi(bgw[i].y), bf_lo(bgw[i].z), bf_hi(bgw[i].z), bf_lo(bgw[i].w), bf_hi(bgw[i].w)};
              float o[8];
#pragma unroll
              for (int q = 0; q < 8; ++q) o[q] = bgv[q] * (k0[q] * y[i][q] + k1[q] * y[i + 1][q] + k2[q] * y[i + 2][q]);
              store8(BR + (size_t)(r0 + i) * 2560 + 2048 + c0, o); } }
        { float s[4][8], cnt[4];
#pragma unroll
          for (int i = 0; i < 4; ++i) { cnt[i] = 0.f;
#pragma unroll
              for (int q = 0; q < 8; ++q) s[i][q] = 0.f; }
#pragma unroll
          for (int j = 0; j < 19; ++j) { const int d = j - 8, pr = pos0 + d; const bool inseq = pr >= 0 && pr < gr.L;
              const float x[8] = {bf_lo(pw_[j].x), bf_hi(pw_[j].x), bf_lo(pw_[j].y), bf_hi(pw_[j].y), bf_lo(pw_[j].z), bf_hi(pw_[j].z), bf_lo(pw_[j].w), bf_hi(pw_[j].w)};
#pragma unroll
              for (int i = 0; i < 4; ++i) { if (d - i < -8 || d - i > 7) continue;
                  const float mk = (inseq && d - i >= -wh && d - i <= wh - 1) ? 1.0f : 0.0f; cnt[i] += mk;
#pragma unroll
                  for (int q = 0; q < 8; ++q) s[i][q] += mk * x[q]; } }
#pragma unroll
          for (int i = 0; i < 4; ++i) { const float inv = 1.0f / cnt[i]; const u32x4 w = pw_[8 + i];
              const float x[8] = {bf_lo(w.x), bf_hi(w.x), bf_lo(w.y), bf_hi(w.y), bf_lo(w.z), bf_hi(w.z), bf_lo(w.w), bf_hi(w.w)};
              float o[8];
#pragma unroll
              for (int q = 0; q < 8; ++q) o[q] = s[i][q] * inv - x[q];
              store8(BR + (size_t)(r0 + i) * 2560 + 1024 + c0, o); } }
    }
    {
        constexpr int VS = 272;
        LAS unsigned char* vt = F.lds;
        const bf16_t* WSP = (const bf16_t*)(F.ws + WS_W0 + OFF_WSP);
        const float* sgn = F.in[I_SGUN] + l * 512; const float* bsp = F.in[I_BSP] + l * 512;
        const int nun = (gr.rows >> 7) * 4;
        const int fr = lane & 15, fq = lane >> 4, wq = F.wave >> 1, wcn = F.wave & 1;
        u32x4 wv[16];
        if (F.bx < nun) { const int r0 = (F.bx >> 2) * 128;
#pragma unroll
            for (int pp = 0; pp < 16; ++pp) wv[pp] = *(const u32x4*)(Z + (size_t)(r0 + 16 * F.wave + pp) * 4096 + 2048 + 8 * lane); }
        for (int un = F.bx; un < nun; un += F.G) {
            const int ch = un >> 2, gq = un & 3, r0 = ch * 128;
            bf16x8 af[4][2]; u32x2 uw[2][4];
#pragma unroll
            for (int ks = 0; ks < 4; ++ks)
#pragma unroll
                for (int m = 0; m < 2; ++m) af[ks][m] = *(const bf16x8*)(WSP + ((size_t)gq * 128 + 32 * wq + 16 * m + fr) * 128 + 32 * ks + 8 * fq);
#pragma unroll
            for (int m = 0; m < 2; ++m)
#pragma unroll
                for (int n = 0; n < 4; ++n) uw[m][n] = *(const u32x2*)(Z + (size_t)(r0 + 32 * wq + 16 * m + fr) * 4096 + 1536 + gq * 128 + 64 * wcn + 16 * n + 4 * fq);
            const int cl = 8 * (lane & 15);
            const f32x4 n0 = *(const f32x4*)(sgn + gq * 128 + cl), n1 = *(const f32x4*)(sgn + gq * 128 + cl + 4);
            const float bq0 = bsp[gq * 128 + 32 * wq + fr], bq1 = bsp[gq * 128 + 32 * wq + 16 + fr];
            __syncthreads();
#pragma unroll
            for (int g4 = 0; g4 < 4; ++g4) {
                float nv[4][8];
#pragma unroll
                for (int q4 = 0; q4 < 4; ++q4) { const u32x4 w = wv[4 * g4 + q4];
                    float v[8] = {bf_lo(w.x), bf_hi(w.x), bf_lo(w.y), bf_hi(w.y), bf_lo(w.z), bf_hi(w.z), bf_lo(w.w), bf_hi(w.w)};
                    float ss = 0.f;
#pragma unroll
                    for (int j = 0; j < 8; ++j) { v[j] = gelu_tanh(v[j]); ss += v[j] * v[j]; }
                    const float rstd = rsqrtf(wave_sum(ss) * (1.0f / 512.0f) + EPS);
#pragma unroll
                    for (int j = 0; j < 8; ++j) nv[q4][j] = v[j] * rstd * (j < 4 ? n0[j & 3] : n1[j & 3]); }
                if ((lane >> 4) == gq) { const int p0 = 16 * F.wave + 4 * g4;
                    LAS unsigned char* dst = vt + cl * VS + ((((p0 >> 3) ^ (lane & 7)) << 4) | ((p0 & 4) << 1));
#pragma unroll
                    for (int j = 0; j < 8; ++j) *(LAS u32x2*)(dst + j * VS) = (u32x2){cvt_pk_bf16(nv[0][j], nv[1][j]), cvt_pk_bf16(nv[2][j], nv[3][j])}; }
            }
            if (un + F.G < nun) { const int r1 = ((un + F.G) >> 2) * 128;
#pragma unroll
                for (int pp = 0; pp < 16; ++pp) wv[pp] = *(const u32x4*)(Z + (size_t)(r1 + 16 * F.wave + pp) * 4096 + 2048 + 8 * lane); }
            __syncthreads();
            f32x4 acc[2][4];
#pragma unroll
            for (int m = 0; m < 2; ++m)
#pragma unroll
                for (int n = 0; n < 4; ++n) acc[m][n] = (f32x4){0.f, 0.f, 0.f, 0.f};
#pragma unroll
            for (int ks = 0; ks < 4; ++ks) {
                bf16x8 bfr[4];
#pragma unroll
                for (int n = 0; n < 4; ++n) bfr[n] = *(const LAS bf16x8*)(vt + (64 * wcn + 16 * n + fr) * VS + (((4 * ks + fq) ^ ((2 * n + (fr >> 3)) & 7)) << 4));
#pragma unroll
                for (int m = 0; m < 2; ++m)
#pragma unroll
                    for (int n = 0; n < 4; ++n) acc[m][n] = __builtin_amdgcn_mfma_f32_16x16x32_bf16(bfr[n], af[ks][m], acc[m][n], 0, 0, 0);
            }
#pragma unroll
            for (int m = 0; m < 2; ++m) { const int q = 32 * wq + 16 * m + fr; const float bq = m == 0 ? bq0 : bq1;
#pragma unroll
                for (int n = 0; n < 4; ++n) { const int c = 64 * wcn + 16 * n + 4 * fq;
                    const u32x2 u2 = uw[m][n];
                    const float o0 = gelu_tanh(bf_lo(u2.x)) * (acc[m][n][0] + bq), o1 = gelu_tanh(bf_hi(u2.x)) * (acc[m][n][1] + bq),
                                o2 = gelu_tanh(bf_lo(u2.y)) * (acc[m][n][2] + bq), o3 = gelu_tanh(bf_hi(u2.y)) * (acc[m][n][3] + bq);
                    u32x2 ow; ow.x = cvt_pk_bf16(o0, o1); ow.y = cvt_pk_bf16(o2, o3);
                    *(u32x2*)(BR + (size_t)(r0 + q) * 2560 + 1536 + gq * 128 + c) = ow; } }
        }
        __syncthreads();
    }
}

__device__ __forceinline__ void thin_c(Frame& F, int l, int g) {
    const Grp gr = grp_of(g);
    unsigned char* gb = F.ws + WS_G;
    bf16_t* QB = (bf16_t*)(gb + G_Q); const bf16_t* KN = (const bf16_t*)(gb + G_KN); bf16_t* KB = (bf16_t*)(gb + G_K); const bf16_t* Z = (const bf16_t*)(gb + G_Z);
    const bf16_t* KP = (const bf16_t*)(F.ws + WS_KPE);
    const float* qn = F.in[I_QN] + l * QKH; const float* kn = F.in[I_KN] + l * QKH;
    const int lane = F.lane, hd = lane >> 2, j4 = lane & 3;
    const float QSCALE = 0.10206207261596577f * 1.4426950408889634f;
    float qw[32], kw[32];
#pragma unroll
    for (int i = 0; i < 16; ++i) { qw[i] = qn[16 * j4 + i]; kw[i] = kn[16 * j4 + i]; }
#pragma unroll
    for (int i = 0; i < 8; ++i) { qw[16 + i] = qn[64 + 8 * j4 + i]; qw[24 + i] = qn[64 + 8 * (j4 ^ 1) + i]; kw[16 + i] = kn[64 + 8 * j4 + i]; kw[24 + i] = kn[64 + 8 * (j4 ^ 1) + i]; }
    struct Row { u32x4 qa, qb, qo, qp, ka, kb, ko, kp; u32x2 z0, z1, z2; };
#define TC_LOAD(R, r) do { const bf16_t* qp_ = QB + (size_t)(r) * 1536 + hd * QKH; const bf16_t* zr_ = Z + (size_t)(r) * 4096; const bf16_t* kp_ = KN + (size_t)(r) * 1024 + hd * 64; const bf16_t* pe_ = KP + (size_t)(gr.row0 + (r)) * 32; \
        R.qa = *(const u32x4*)(qp_ + 16 * j4); R.qb = *(const u32x4*)(qp_ + 16 * j4 + 8); R.qo = *(const u32x4*)(qp_ + 64 + 8 * j4); R.qp = *(const u32x4*)(qp_ + 64 + 8 * (j4 ^ 1)); \
        R.z0 = *(const u32x2*)(zr_ + 12 * lane); R.z1 = *(const u32x2*)(zr_ + 12 * lane + 4); R.z2 = *(const u32x2*)(zr_ + 12 * lane + 8); \
        R.ka = *(const u32x4*)(kp_ + 16 * j4); R.kb = *(const u32x4*)(kp_ + 16 * j4 + 8); R.ko = *(const u32x4*)(pe_ + 8 * j4); R.kp = *(const u32x4*)(pe_ + 8 * (j4 ^ 1)); } while (0)
#define TC_UNPACK(W_, V_) do { const u32x4 t_ = (W_); V_[0] = bf_lo(t_.x); V_[1] = bf_hi(t_.x); V_[2] = bf_lo(t_.y); V_[3] = bf_hi(t_.y); V_[4] = bf_lo(t_.z); V_[5] = bf_hi(t_.z); V_[6] = bf_lo(t_.w); V_[7] = bf_hi(t_.w); } while (0)
#define TC_ROPE_TAB(pos) float cs[8] = {1.f,1.f,1.f,1.f,1.f,1.f,1.f,1.f}, sn[8] = {0.f,0.f,0.f,0.f,0.f,0.f,0.f,0.f}; \
        if (rope) { const float pv = (float)((j4 >> 1) == 0 ? ((pos) >> 6) : ((pos) & 63)); \
            _Pragma("unroll") for (int f = 0; f < 8; ++f) { const float ang = pv * __builtin_amdgcn_exp2f(-1.6609640474436813f * (float)f); cs[f] = __cosf(ang); sn[f] = __sinf(ang); } }
#define TC_FINISH(a, b, o, p, wv, scale, dst) do { float ss = 0.f; \
        _Pragma("unroll") for (int i = 0; i < 8; ++i) ss += a[i] * a[i] + b[i] * b[i] + o[i] * o[i]; \
        ss = quad_sum(ss); \
        const float rn = rsqrtf(ss * (1.0f / QKH) + EPS) * (scale); \
        _Pragma("unroll") for (int i = 0; i < 8; ++i) { a[i] *= rn * wv[i]; b[i] *= rn * wv[8 + i]; o[i] *= rn * wv[16 + i]; p[i] *= rn * wv[24 + i]; } \
        if (rope) { _Pragma("unroll") for (int i = 0; i < 8; ++i) o[i] = (j4 & 1) ? o[i] * cs[i] + p[i] * sn[i] : o[i] * cs[i] - p[i] * sn[i]; } \
        store8((dst) + 16 * j4, a); store8((dst) + 16 * j4 + 8, b); store8((dst) + 64 + 8 * j4, o); } while (0)
#define TC_COMPUTE(R, r) do { const bool rope = (g != 0); const int pos = (r) % gr.L; TC_ROPE_TAB(pos) \
        float s2 = 0.f; { const float a0 = bf_lo(R.z0.x), a1 = bf_hi(R.z0.x), a2 = bf_lo(R.z0.y), a3 = bf_hi(R.z0.y), a4 = bf_lo(R.z1.x), a5 = bf_hi(R.z1.x), a6 = bf_lo(R.z1.y), a7 = bf_hi(R.z1.y), a8 = bf_lo(R.z2.x), a9 = bf_hi(R.z2.x), a10 = bf_lo(R.z2.y), a11 = bf_hi(R.z2.y); \
            s2 = ((a0 * a0 + a1 * a1) + (a2 * a2 + a3 * a3)) + ((a4 * a4 + a5 * a5) + (a6 * a6 + a7 * a7)) + ((a8 * a8 + a9 * a9) + (a10 * a10 + a11 * a11)); } \
        const float rq = rsqrtf(wave_sum(s2) * (1.0f / QLORA) + EPS); \
        { float a[8], b[8], o[8], p[8]; TC_UNPACK(R.qa, a); TC_UNPACK(R.qb, b); TC_UNPACK(R.qo, o); TC_UNPACK(R.qp, p); \
          _Pragma("unroll") for (int i = 0; i < 8; ++i) { a[i] *= rq; b[i] *= rq; o[i] *= rq; p[i] *= rq; } \
          bf16_t* qd = QB + (size_t)(r) * 1536 + hd * QKH; TC_FINISH(a, b, o, p, qw, QSCALE, qd); } \
        { float a[8], b[8], o[8], p[8]; TC_UNPACK(R.ka, a); TC_UNPACK(R.kb, b); TC_UNPACK(R.ko, o); TC_UNPACK(R.kp, p); \
          bf16_t* kd = KB + (size_t)(r) * 1536 + hd * QKH; TC_FINISH(a, b, o, p, kw, 1.0f, kd); } } while (0)
    {
        Row R0, R1; int r = F.gw;
        if (r < gr.rows) TC_LOAD(R0, r);
        for (; r < gr.rows; r += 2 * F.ngw) {
            const int r1 = r + F.ngw, r2 = r + 2 * F.ngw;
            if (r1 < gr.rows) TC_LOAD(R1, r1);
            TC_COMPUTE(R0, r);
            if (r2 < gr.rows) TC_LOAD(R0, r2);
            if (r1 < gr.rows) TC_COMPUTE(R1, r1);
        }
    }
    for (int r = gr.rows + F.gw; r < gr.tkv; r += F.ngw) {
        const bool rope = false; float cs[8] = {1.f,1.f,1.f,1.f,1.f,1.f,1.f,1.f}, sn[8] = {0.f,0.f,0.f,0.f,0.f,0.f,0.f,0.f};
        const bf16_t* kp = KN + (size_t)r * 1024 + hd * 64;
        float a[8], b[8], o[8], p[8];
        load8(kp + 16 * j4, a); load8(kp + 16 * j4 + 8, b);
        { const int ci = r - gr.rows, sq = ci >> 8, pp = ci & 255, bb = 4 * (g - 1) + sq; const float* pe = F.in[I_CKPE] + (((size_t)bb * 2 + l) * 256 + pp) * 32;
#pragma unroll
          for (int i = 0; i < 8; ++i) { o[i] = pe[8 * j4 + i]; p[i] = pe[8 * (j4 ^ 1) + i]; } }
        bf16_t* kd = KB + (size_t)r * 1536 + hd * QKH; TC_FINISH(a, b, o, p, kw, 1.0f, kd);
    }
#undef TC_LOAD
#undef TC_UNPACK
#undef TC_ROPE_TAB
#undef TC_FINISH
#undef TC_COMPUTE
}

__device__ __forceinline__ void attn_phase(Frame& F, int g) {
    const Grp gr = grp_of(g);
    unsigned char* gb = F.ws + WS_G;
    const bf16_t* Q = (const bf16_t*)(gb + G_Q); const bf16_t* K = (const bf16_t*)(gb + G_K); const bf16_t* VT = (const bf16_t*)(gb + G_VT); bf16_t* BR = (bf16_t*)(gb + G_BR);
    constexpr int KS = 208, VS = 136, KBUF = 64 * KS, VBUF = 64 * VS;
    LAS unsigned char* kl = F.lds; LAS unsigned char* vl = F.lds + 2 * KBUF;
    const int tid = F.tid, lane = F.lane, wid = F.wave, r32 = lane & 31, hh = lane >> 5;
    const bool late = wid >= 4;
    const int qblocks = gr.L >> 8, nunits = gr.nseq * NH * qblocks, ntl = gr.L >> 6, nt = (gr.L + gr.C) >> 6;
    const int vcu = (F.G & 7) == 0 ? (F.bx & 7) * (F.G >> 3) + (F.bx >> 3) : F.bx;
    const int k0key = tid / 12, k0part = tid % 12, k1key = (tid + 512) / 12, k1part = (tid + 512) % 12; const bool k1v = tid < 256;
    const int vd = tid >> 3, vpart = tid & 7;
#define ATT_LOADG(t, Kh_, Vh_, srow0_, crow0_, kr0, kr1, vr) do { if ((t) < nt) { const int kb_ = (t) < ntl ? (srow0_) + 64 * (t) : (crow0_) + 64 * ((t) - ntl); \
        kr0 = *(const u32x4*)((Kh_) + (size_t)(kb_ + k0key) * 1536 + 8 * k0part); if (k1v) kr1 = *(const u32x4*)((Kh_) + (size_t)(kb_ + k1key) * 1536 + 8 * k1part); \
        vr = *(const u32x4*)((Vh_) + kb_); } } while (0)
#define ATT_UNIT_IDX(u_, qb_, head_, srow0_, crow0_) const int qb_ = (u_) % qblocks, sh##qb_ = (u_) / qblocks, head_ = sh##qb_ % NH, sq##qb_ = sh##qb_ / NH, srow0_ = sq##qb_ * gr.L, crow0_ = gr.rows + sq##qb_ * gr.C
#define ATT_QLOAD(qb_, head_, srow0_) do { const bf16_t* qp_ = Q + (size_t)((srow0_) + 256 * (qb_) + 32 * wid + r32) * 1536 + (head_) * QKH + 8 * hh; \
        _Pragma("unroll") for (int s = 0; s < 6; ++s) qf[s] = *(const bf16x8*)(qp_ + 16 * s); } while (0)
    bf16x8 qf[6];
    u32x4 ka0, ka1 = {0u, 0u, 0u, 0u}, va_, kb0, kb1 = {0u, 0u, 0u, 0u}, vb_;
    volatile LAS unsigned* flagw = (volatile LAS unsigned*)(F.lds + LDS_MISC) + 48;
    if (tid == 0) { flagw[0] = 0u; flagw[1] = 0u; }
    if (vcu < nunits) { ATT_UNIT_IDX(vcu, qb0, head0, srow00, crow00);
        ATT_LOADG(0, K + head0 * QKH, VT + (size_t)(head0 * 64 + vd) * gr.tkv + 8 * vpart, srow00, crow00, ka0, ka1, va_); }
    unsigned par = 0;
    for (int un = vcu; un < nunits; un += F.G, par ^= 1u) {
        ATT_UNIT_IDX(un, qb, head, srow0, crow0);
        const bf16_t* Kh = K + head * QKH; const bf16_t* Vh = VT + (size_t)(head * 64 + vd) * gr.tkv + 8 * vpart;
        ATT_QLOAD(qb, head, srow0);
#define ATT_LOAD(t, kr0, kr1, vr) ATT_LOADG(t, Kh, Vh, srow0, crow0, kr0, kr1, vr)
#define ATT_STORE(t, kbo, vbo, kr0, kr1, vr) do { if ((t) < nt) { *(LAS u32x4*)(kl + (kbo) + k0key * KS + 16 * k0part) = kr0; if (k1v) *(LAS u32x4*)(kl + (kbo) + k1key * KS + 16 * k1part) = kr1; \
        *(LAS u32x2*)(vl + (vbo) + vd * VS + 16 * vpart) = (u32x2){vr.x, vr.y}; *(LAS u32x2*)(vl + (vbo) + vd * VS + 16 * vpart + 8) = (u32x2){vr.z, vr.w}; } } while (0)
        const f32x16 z16 = {0.f,0.f,0.f,0.f,0.f,0.f,0.f,0.f,0.f,0.f,0.f,0.f,0.f,0.f,0.f,0.f};
        float m_run, l_run, ts_prev; bool first;
        f32x16 negm, o0, o1, p0, p1;
        u32x4 pw[2][2];
#define ATT_X(kbo) do { LAS unsigned char* kb = kl + (kbo); \
            _Pragma("unroll") for (int s = 0; s < 6; ++s) { \
                const bf16x8 ka = *(const LAS bf16x8*)(kb + r32 * KS + 32 * s + 16 * hh), kc = *(const LAS bf16x8*)(kb + (32 + r32) * KS + 32 * s + 16 * hh); \
                p0 = __builtin_amdgcn_mfma_f32_32x32x16_bf16(ka, qf[s], s == 0 ? negm : p0, 0, 0, 0); p1 = __builtin_amdgcn_mfma_f32_32x32x16_bf16(kc, qf[s], s == 0 ? negm : p1, 0, 0, 0); } } while (0)
#define ATT_YS() do { float mx = p0[0]; \
            _Pragma("unroll") for (int i = 1; i < 16; ++i) mx = fmaxf(mx, p0[i]); \
            _Pragma("unroll") for (int i = 0; i < 16; ++i) mx = fmaxf(mx, p1[i]); \
            { auto rr = __builtin_amdgcn_permlane32_swap(__float_as_uint(mx), __float_as_uint(mx), false, false); mx = fmaxf(__uint_as_float(rr[0]), __uint_as_float(rr[1])); } \
            if (first || __builtin_amdgcn_ballot_w64(mx > 5.0f) != 0ull) {            \
                const float dl = first ? mx : fmaxf(mx, 0.f); const float al = __builtin_amdgcn_exp2f(-dl); \
                m_run += dl; l_run *= al; o0 *= al; o1 *= al; p0 = p0 - dl; p1 = p1 - dl; \
                _Pragma("unroll") for (int i = 0; i < 16; ++i) negm[i] = -m_run; first = false; } \
            _Pragma("unroll") for (int i = 0; i < 16; ++i) { p0[i] = __builtin_amdgcn_exp2f(p0[i]); p1[i] = __builtin_amdgcn_exp2f(p1[i]); } \
            { const f32x16 s16 = p0 + p1; \
              const f32x4 s4 = (f32x4){s16[0], s16[1], s16[2], s16[3]} + (f32x4){s16[4], s16[5], s16[6], s16[7]} + (f32x4){s16[8], s16[9], s16[10], s16[11]} + (f32x4){s16[12], s16[13], s16[14], s16[15]}; \
              l_run += (s4[0] + s4[1]) + (s4[2] + s4[3]); } \
            _Pragma("unroll") for (int s2 = 0; s2 < 2; ++s2) { \
                pw[0][s2] = (u32x4){cvt_pk_bf16(p0[8 * s2], p0[8 * s2 + 1]), cvt_pk_bf16(p0[8 * s2 + 2], p0[8 * s2 + 3]), cvt_pk_bf16(p0[8 * s2 + 4], p0[8 * s2 + 5]), cvt_pk_bf16(p0[8 * s2 + 6], p0[8 * s2 + 7])}; \
                pw[1][s2] = (u32x4){cvt_pk_bf16(p1[8 * s2], p1[8 * s2 + 1]), cvt_pk_bf16(p1[8 * s2 + 2], p1[8 * s2 + 3]), cvt_pk_bf16(p1[8 * s2 + 4], p1[8 * s2 + 5]), cvt_pk_bf16(p1[8 * s2 + 6], p1[8 * s2 + 7])}; } } while (0)
#define ATT_YF() do { \
            if (first) { float mx = p0[0]; \
                _Pragma("unroll") for (int i = 1; i < 16; ++i) mx = fmaxf(mx, p0[i]); \
                _Pragma("unroll") for (int i = 0; i < 16; ++i) mx = fmaxf(mx, p1[i]); \
                { auto rr = __builtin_amdgcn_permlane32_swap(__float_as_uint(mx), __float_as_uint(mx), false, false); mx = fmaxf(__uint_as_float(rr[0]), __uint_as_float(rr[1])); } \
                m_run = mx; p0 = p0 - mx; p1 = p1 - mx; \
                _Pragma("unroll") for (int i = 0; i < 16; ++i) negm[i] = -m_run; first = false; } \
            else if (__builtin_amdgcn_ballot_w64(!(ts_prev < ATT_BIG)) != 0ull) { \
                float tsr; { auto rr = __builtin_amdgcn_permlane32_swap(__float_as_uint(ts_prev), __float_as_uint(ts_prev), false, false); tsr = __uint_as_float(rr[0]) + __uint_as_float(rr[1]); }     \
                const float dl = !(tsr < ATT_BIG) ? (float)((int)((__float_as_uint(tsr) >> 23) & 255u) - 127) : 0.f; const float al = __builtin_amdgcn_exp2f(-dl); \
                m_run += dl; l_run *= al; o0 *= al; o1 *= al; p0 = p0 - dl; p1 = p1 - dl; \
                _Pragma("unroll") for (int i = 0; i < 16; ++i) negm[i] = -m_run; } \
            _Pragma("unroll") for (int i = 0; i < 16; ++i) { p0[i] = __builtin_amdgcn_exp2f(p0[i]); p1[i] = __builtin_amdgcn_exp2f(p1[i]); } \
            { const f32x16 s16 = p0 + p1; \
              const f32x4 s4 = (f32x4){s16[0], s16[1], s16[2], s16[3]} + (f32x4){s16[4], s16[5], s16[6], s16[7]} + (f32x4){s16[8], s16[9], s16[10], s16[11]} + (f32x4){s16[12], s16[13], s16[14], s16[15]}; \
              ts_prev = (s4[0] + s4[1]) + (s4[2] + s4[3]); l_run += ts_prev; } \
            _Pragma("unroll") for (int s2 = 0; s2 < 2; ++s2) { \
                pw[0][s2] = (u32x4){cvt_pk_bf16(p0[8 * s2], p0[8 * s2 + 1]), cvt_pk_bf16(p0[8 * s2 + 2], p0[8 * s2 + 3]), cvt_pk_bf16(p0[8 * s2 + 4], p0[8 * s2 + 5]), cvt_pk_bf16(p0[8 * s2 + 6], p0[8 * s2 + 7])}; \
                pw[1][s2] = (u32x4){cvt_pk_bf16(p1[8 * s2], p1[8 * s2 + 1]), cvt_pk_bf16(p1[8 * s2 + 2], p1[8 * s2 + 3]), cvt_pk_bf16(p1[8 * s2 + 4], p1[8 * s2 + 5]), cvt_pk_bf16(p1[8 * s2 + 6], p1[8 * s2 + 7])}; } } while (0)
#define ATT_Z(vbo) do { LAS unsigned char* vb = vl + (vbo); \
            _Pragma("unroll") for (int kbk = 0; kbk < 2; ++kbk) \
            _Pragma("unroll") for (int s2 = 0; s2 < 2; ++s2) { const int kbase = (32 * kbk + 16 * s2 + 4 * hh) * 2; \
                    const u32x2 a0 = *(const LAS u32x2*)(vb + r32 * VS + kbase), a1 = *(const LAS u32x2*)(vb + r32 * VS + kbase + 16); \
                    const u32x2 c0 = *(const LAS u32x2*)(vb + (32 + r32) * VS + kbase), c1 = *(const LAS u32x2*)(vb + (32 + r32) * VS + kbase + 16); \
                    const u32x4 va = {a0.x, a0.y, a1.x, a1.y}, vc = {c0.x, c0.y, c1.x, c1.y}; \
                    const bf16x8 pb = __builtin_bit_cast(bf16x8, pw[kbk][s2]); \
                    o0 = __builtin_amdgcn_mfma_f32_32x32x16_bf16(__builtin_bit_cast(bf16x8, va), pb, o0, 0, 0, 0); \
                    o1 = __builtin_amdgcn_mfma_f32_32x32x16_bf16(__builtin_bit_cast(bf16x8, vc), pb, o1, 0, 0, 0); } } while (0)
        int kcur, vprev, vcur, vnext;
#define ATT_ROT() do { kcur ^= KBUF; vprev = vcur; vcur = vnext; vnext = (vnext == 2 * VBUF) ? 0 : vnext + VBUF; } while (0)
#define ATT_UNIT(YM) do { m_run = 0.f; l_run = 0.f; ts_prev = 0.f; first = true; negm = z16; o0 = z16; o1 = z16; p0 = z16; p1 = z16; \
        ATT_STORE(0, 0, 0, ka0, ka1, va_); ATT_LOAD(1, kb0, kb1, vb_); \
        __syncthreads(); \
        kcur = 0; vprev = 2 * VBUF; vcur = 0; vnext = VBUF; \
        if (!late) { \
            for (int t = 0; t < nt; t += 2) { \
                ATT_LOAD(t + 2, ka0, ka1, va_); \
                ATT_X(kcur); YM(); ATT_Z(vcur); \
                ATT_STORE(t + 1, kcur ^ KBUF, vnext, kb0, kb1, vb_); \
                __syncthreads(); ATT_ROT(); \
                ATT_LOAD(t + 3, kb0, kb1, vb_); \
                ATT_X(kcur); YM(); ATT_Z(vcur); \
                ATT_STORE(t + 2, kcur ^ KBUF, vnext, ka0, ka1, va_); \
                __syncthreads(); ATT_ROT(); \
            } \
        } else { \
            for (int t = 0; t < nt; t += 2) { \
                ATT_LOAD(t + 2, ka0, ka1, va_); \
                if (t > 0) { YM(); ATT_Z(vprev); } \
                ATT_X(kcur); \
                ATT_STORE(t + 1, kcur ^ KBUF, vnext, kb0, kb1, vb_); \
                __syncthreads(); ATT_ROT(); \
                ATT_LOAD(t + 3, kb0, kb1, vb_); \
                YM(); ATT_Z(vprev); \
                ATT_X(kcur); \
                ATT_STORE(t + 2, kcur ^ KBUF, vnext, ka0, ka1, va_); \
                __syncthreads(); ATT_ROT(); \
            } \
            YM(); ATT_Z(vprev); \
        } \
        } while (0)
        ATT_UNIT(ATT_YF);
#define ATT_PREFETCH_NEXT() do { if (un + F.G < nunits) { ATT_UNIT_IDX(un + F.G, qbn, headn, srow0n, crow0n); \
            ATT_LOADG(0, K + headn * QKH, VT + (size_t)(headn * 64 + vd) * gr.tkv + 8 * vpart, srow0n, crow0n, ka0, ka1, va_); } } while (0)
        ATT_PREFETCH_NEXT();
        {
            float chk = l_run;
#pragma unroll
            for (int i = 0; i < 16; ++i) chk += __builtin_fabsf(o0[i]) + __builtin_fabsf(o1[i]);
            if (__builtin_amdgcn_ballot_w64(!(chk < ATT_CHK)) != 0ull && lane == 0) flagw[par] = 1u;
            __syncthreads();
            const unsigned redo = flagw[par];
            if (tid == 0) flagw[par ^ 1u] = 0u;
            if (redo) { ATT_LOAD(0, ka0, ka1, va_); ATT_UNIT(ATT_YS); ATT_PREFETCH_NEXT(); __syncthreads(); }
        }
#undef ATT_PREFETCH_NEXT
#undef ATT_ROT
#undef ATT_LOAD
#undef ATT_STORE
#undef ATT_X
#undef ATT_YS
#undef ATT_YF
#undef ATT_UNIT
#undef ATT_Z
        { auto rr = __builtin_amdgcn_permlane32_swap(__float_as_uint(l_run), __float_as_uint(l_run), false, false); l_run = __uint_as_float(rr[0]) + __uint_as_float(rr[1]); }
        const float il = 1.0f / l_run;
        bf16_t* op = BR + (size_t)(srow0 + 256 * qb + 32 * wid + r32) * 2560 + head * 64;
#pragma unroll
        for (int gq = 0; gq < 4; ++gq) { const int d0 = 8 * gq + 4 * hh;
            u32x2 w0; w0.x = cvt_pk_bf16(o0[4 * gq] * il, o0[4 * gq + 1] * il); w0.y = cvt_pk_bf16(o0[4 * gq + 2] * il, o0[4 * gq + 3] * il); *(u32x2*)(op + d0) = w0;
            u32x2 w1; w1.x = cvt_pk_bf16(o1[4 * gq] * il, o1[4 * gq + 1] * il); w1.y = cvt_pk_bf16(o1[4 * gq + 2] * il, o1[4 * gq + 3] * il); *(u32x2*)(op + 32 + d0) = w1; }
    }
    __syncthreads();
#undef ATT_LOADG
#undef ATT_UNIT_IDX
#undef ATT_QLOAD
}

constexpr int STEPS_PER_GROUP = 7, STEPS_PER_LAYER = 2 + NGRP * STEPS_PER_GROUP + 3, NSTEPS = NLAYER * STEPS_PER_LAYER;

__global__ void __launch_bounds__(NTHR, 2) mk_fwd(Args args) {
    extern __shared__ __attribute__((aligned(16))) unsigned char lds_raw[];
    Frame F;
    F.lds = (LAS unsigned char*)lds_raw;
    F.tid = threadIdx.x; F.lane = F.tid & 63; F.wave = __builtin_amdgcn_readfirstlane(F.tid >> 6);
    F.bx = blockIdx.x; F.G = gridDim.x; F.gw = F.bx * NWAVE + F.wave; F.ngw = F.G * NWAVE;
    F.in = args.in; F.out = args.out; F.ws = args.ws;
    volatile LAS unsigned* misc = (volatile LAS unsigned*)(F.lds + LDS_MISC);
    if (F.tid < 64) misc[F.tid] = 0u;
    __syncthreads();
    XcdBarrier bar; bar.bar = (unsigned*)(F.ws + WS_CTL) + 1024; bar.x = 0; bar.st = misc + 8;
#if !MK_MULTI
    bar = xcd_barrier_post((unsigned*)(F.ws + WS_CTL) + 1024, misc + 8);
#endif
    const int lo = args.step_lo, hi = args.step_hi;
#define IN(s) (lo <= (s) && (s) < hi)
#if MK_MULTI
#define SEAM(s) do { } while (0)
#else
#define SEAM(s) do { if (IN(s) && IN((s) + 1)) xcd_barrier(bar); } while (0)
#endif
    for (int l0 = 0; l0 < NLAYER; ++l0) {
        const int sp = l0 * STEPS_PER_LAYER, sl = sp + 1;
        if (IN(sp)) { Frame P = fresh(F); int l = l0; LAUNDER_S(l); p0_prologue(P, l); } SEAM(sp);
        if (IN(sl)) { { Frame P = fresh(F); int l = l0; LAUNDER_S(l);
            if (l == 0) thin_norm<true, false>(P, l, P.in[I_XP], P.in[I_XS], P.in[I_NMIX] + l * DM, 0, 1);
            else thin_norm<true, true>(P, l, nullptr, nullptr, P.in[I_NMIX] + l * DM, 0, 1); } } SEAM(sl);
        for (int g0 = 0; g0 < NGRP; ++g0) {
            const int sg = sl + 1 + g0 * STEPS_PER_GROUP;
            if (IN(sg + 0)) { {
                Frame P = fresh(F); int l = l0, g = g0; LAUNDER_S(l); LAUNDER_S(g); const Grp gr = grp_of(g);
                unsigned char* wl = P.ws + WS_W0; unsigned char* gb = P.ws + WS_G;
                pg8::Prob p{(const bf16_t*)(P.ws + WS_H) + (size_t)gr.row0 * DM, (const bf16_t*)(wl + OFF_WIN), DM, DM, DM};
                pg8::StaticOrder S; S.init(gr.rows, 12288, P.G, P.bx, WGM_BIG);
                pg8::EpiZ E{(bf16_t*)(gb + G_Z), (bf16_t*)(gb + G_GATE), P.in[I_BGATE] + (size_t)l * 8192};
                pg8::gemm_phase(P.lds, p, S, E);
            } } SEAM(sg + 0);
            if (IN(sg + 1)) { { Frame P = fresh(F); int l = l0, g = g0; LAUNDER_S(l); LAUNDER_S(g); thin_b(P, l, g); } } SEAM(sg + 1);
            if (IN(sg + 2)) { {
                Frame P = fresh(F); int l = l0, g = g0; LAUNDER_S(l); LAUNDER_S(g); const Grp gr = grp_of(g);
                unsigned char* wl = P.ws + WS_W0; unsigned char* gb = P.ws + WS_G;
                { pg8::Prob p{(const bf16_t*)(gb + G_Z), (const bf16_t*)(wl + OFF_WUQ), 4096, QLORA, QLORA};
                  pg8::StaticOrder S; S.init(gr.rows, 1536, P.G, P.bx);
                  pg8::EpiStore E{(bf16_t*)(gb + G_Q), 1536};
                  pg8::gemm_phase(P.lds, p, S, E); }
                { pg8::Prob p{(const bf16_t*)(gb + G_CKV), (const bf16_t*)(wl + OFF_WUK), KVL, KVL, KVL};
                  pg8::StaticOrder S; S.init(gr.tkv, 1024, P.G, (P.bx + (g == 0 ? 160 : 128)) % P.G);
                  pg8::EpiStore E{(bf16_t*)(gb + G_KN), 1024};
                  pg8::gemm_phase(P.lds, p, S, E); }
                { pg8::Prob p{(const bf16_t*)(wl + OFF_WUV), (const bf16_t*)(gb + G_CKV), KVL, KVL, KVL};
                  pg8::StaticOrder S; S.init(1024, gr.tkv, P.G, (P.bx + (g == 0 ? 96 : 112)) % P.G);
                  pg8::EpiStore E{(bf16_t*)(gb + G_VT), gr.tkv};
                  pg8::gemm_phase(P.lds, p, S, E); }
            } } SEAM(sg + 2);
            if (IN(sg + 3)) { Frame P = fresh(F); int l = l0, g = g0; LAUNDER_S(l); LAUNDER_S(g); thin_c(P, l, g); } SEAM(sg + 3);
            if (IN(sg + 4)) { { Frame P = fresh(F); int g = g0; LAUNDER_S(g); attn_phase(P, g); } } SEAM(sg + 4);
            if (IN(sg + 5)) { {
                Frame P = fresh(F); int l = l0, g = g0; LAUNDER_S(l); LAUNDER_S(g); const Grp gr = grp_of(g);
                unsigned char* wl = P.ws + WS_W0; unsigned char* gb = P.ws + WS_G;
                pg8::ProbSeg p{(const bf16_t*)(gb + G_BR), (const bf16_t*)(wl + OFF_WBR), 2560, 2560};
                pg8::SegOrder S; S.init(gr.rows, DM, P.G, P.bx, WGM_SMALL);
                pg8::EpiMerge E{(const unsigned char*)(gb + G_GATE), (bf16_t*)(gb + G_M)};
                pg8::gemm_phase(P.lds, p, S, E);
            } } SEAM(sg + 5);
            if (IN(sg + 6)) {
                Frame P = fresh(F); int l = l0, g = g0; LAUNDER_S(l); LAUNDER_S(g); const Grp gr = grp_of(g);
                unsigned char* wl = P.ws + WS_W0; unsigned char* gb = P.ws + WS_G;
                const float* xc = l == 0 ? P.in[I_XP] : nullptr; const float* xl = l == 0 ? P.in[I_XS] : nullptr;
                const float* modl = (const float*)(P.ws + WS_MOD) + (size_t)l * NCOND * 12288;
                pg8::Prob p{(const bf16_t*)(gb + G_M), (const bf16_t*)(wl + OFF_WOUT), DM, DM, DM};
                pg8::StaticOrder S; S.init(gr.rows, DM, P.G, P.bx, WGM_SMALL);
                pg8::EpiResid E{xc, xl, (bf16_t*)(P.ws + WS_XB), nullptr, modl, 2, gr.row0};
                pg8::gemm_phase(P.lds, p, S, E);
            } SEAM(sg + 6);
        }
        const int sf = sl + 1 + NGRP * STEPS_PER_GROUP;
        if (IN(sf)) { { Frame P = fresh(F); int l = l0; LAUNDER_S(l);
            thin_norm<false, true>(P, l, nullptr, nullptr, P.in[I_NFFN] + l * DM, 3, 4); } } SEAM(sf);
        if (IN(sf + 1)) { {
            Frame P = fresh(F); int l = l0; LAUNDER_S(l); unsigned char* wl = P.ws + WS_W0;
            pg8::Prob p{(const bf16_t*)(P.ws + WS_H), (const bf16_t*)(wl + OFF_WFI), DM, DM, DM};
            pg8::StaticOrder S; S.init(TALL, 2 * DFF, P.G, P.bx, WGM_BIG);
            pg8::EpiSwiglu E{(bf16_t*)(P.ws + WS_ACT)};
            pg8::gemm_phase(P.lds, p, S, E);
        } } SEAM(sf + 1);
        if (IN(sf + 2)) {
            Frame P = fresh(F); int l = l0; LAUNDER_S(l); unsigned char* wl = P.ws + WS_W0; float* OUT = P.out;
            const float* modl = (const float*)(P.ws + WS_MOD) + (size_t)l * NCOND * 12288;
            pg8::Prob p{(const bf16_t*)(P.ws + WS_ACT), (const bf16_t*)(wl + OFF_WFO), DFF, DFF, DFF};
            pg8::StaticOrder S; S.init(TALL, DM, P.G, P.bx, WGM_SMALL);
            pg8::EpiResid E{nullptr, nullptr, (bf16_t*)(P.ws + WS_XB), l == NLAYER - 1 ? OUT : nullptr, modl, 5, 0};
            pg8::gemm_phase(P.lds, p, S, E);
        } SEAM(sf + 2);
    }
#undef IN
#undef SEAM
}

extern "C" void kernel_launch(void* const* d_in, const int* in_sizes, int n_in, void* d_out, int out_size, void* d_ws, size_t ws_size, hipStream_t stream) {
    static int grid = 0;
    if (grid == 0) {
        if (n_in != 31 || ws_size < WS_END) { fprintf(stderr, "kernel_launch: n_in %d ws %zu (need %zu)\n", n_in, ws_size, (size_t)WS_END); grid = -1; return; }
        int dev = 0, cus = 0;
        if (hipGetDevice(&dev) != hipSuccess || hipDeviceGetAttribute(&cus, hipDeviceAttributeMultiprocessorCount, dev) != hipSuccess) { grid = -1; return; }
        if (hipFuncSetAttribute((const void*)mk_fwd, hipFuncAttributeMaxDynamicSharedMemorySize, LDS_BYTES) != hipSuccess) { fprintf(stderr, "hipFuncSetAttribute failed\n"); grid = -1; return; }
        int per_cu = 0;
        (void)hipOccupancyMaxActiveBlocksPerMultiprocessor(&per_cu, (const void*)mk_fwd, NTHR, LDS_BYTES);
        (void)hipGetLastError();
        grid = cus < NWG ? cus : NWG;
        if (grid != NWG) fprintf(stderr, "kernel_launch: %d CUs, expected 256\n", cus);
    }
    if (grid < 0) return;
    (void)hipMemsetAsync((char*)d_ws + WS_CTL, 0, CTL_BYTES, stream);
    Args a{};
    for (int i = 0; i < 31; ++i) a.in[i] = (const float*)d_in[i];
    a.out = (float*)d_out; a.ws = (unsigned char*)d_ws;
#if MK_MULTI
    for (int s = 0; s < NSTEPS; ++s) { a.step_lo = s; a.step_hi = s + 1; hipLaunchKernelGGL(mk_fwd, dim3(grid), dim3(NTHR), LDS_BYTES, stream, a); }
#else
    a.step_lo = 0; a.step_hi = NSTEPS;
    hipLaunchKernelGGL(mk_fwd, dim3(grid), dim3(NTHR), LDS_BYTES, stream, a);
#endif
}
```

```cpp
#include <hip/hip_runtime.h>
#include <cstdio>
#include <cstdint>

#define LAS __attribute__((address_space(3)))
#define GAS __attribute__((address_space(1)))
typedef unsigned short bf16_t;
typedef short bf16x8 __attribute__((ext_vector_type(8)));
typedef float f32x2 __attribute__((ext_vector_type(2)));
typedef float f32x4 __attribute__((ext_vector_type(4)));
typedef float f32x16 __attribute__((ext_vector_type(16)));
typedef unsigned u32x2 __attribute__((ext_vector_type(2)));
typedef unsigned u32x4 __attribute__((ext_vector_type(4)));

#ifndef WGM_BIG
#define WGM_BIG 4
#endif
#ifndef WGM_SMALL
#define WGM_SMALL 4
#endif
#ifndef ATT_BIG
#define ATT_BIG 1.0995116e12f
#define ATT_CHK 1.0e37f
#endif
#ifndef MK_MULTI
#define MK_MULTI 0
#endif

constexpr int DM = 2048, TCTX = 4096, TLAT = 32768, TALL = TCTX + TLAT, NINW = 12320, DFF = 5632;
constexpr int NH = 16, QKH = 96, VH = 64, QLORA = 768, KVL = 256, ROPE = 32;
constexpr float EPS = 1e-6f;
constexpr int NLAYER = 2, NCOND = 9, NGRP = 3;
constexpr int GROWS = 16384, GKV = 17408;
constexpr int NWG = 256, NTHR = 512, NWAVE = 8;

constexpr size_t MiB = 1u << 20;
constexpr size_t WS_CTL = 0, CTL_BYTES = 1 * MiB;
constexpr size_t WS_MOD = 1 * MiB;
constexpr size_t WS_W0 = 2 * MiB;
constexpr size_t OFF_WIN = 0;
constexpr size_t OFF_WKPE = OFF_WIN + (size_t)12288 * 2048 * 2;
constexpr size_t OFF_WUQ = OFF_WKPE + (size_t)32 * 2048 * 2;
constexpr size_t OFF_WUK = OFF_WUQ + (size_t)1536 * 768 * 2;
constexpr size_t OFF_WUV = OFF_WUK + (size_t)1024 * 256 * 2;
constexpr size_t OFF_WSP = OFF_WUV + (size_t)1024 * 256 * 2;
constexpr size_t OFF_WBR = OFF_WSP + (size_t)4 * 128 * 128 * 2;
constexpr size_t OFF_WOUT = OFF_WBR + (size_t)2048 * 2560 * 2;
constexpr size_t OFF_WFI = OFF_WOUT + (size_t)2048 * 2048 * 2;
constexpr size_t OFF_WFO = OFF_WFI + (size_t)11264 * 2048 * 2;
constexpr size_t WL_BYTES = OFF_WFO + (size_t)2048 * 5632 * 2;
constexpr size_t WS_H = WS_W0 + WL_BYTES;
constexpr size_t WS_KPE = WS_H + (size_t)TALL * DM * 2;
constexpr size_t WS_G = WS_KPE + (size_t)TALL * 32 * 2;
constexpr size_t G_Z = 0;
constexpr size_t G_GATE = G_Z + (size_t)GROWS * 4096 * 2;
constexpr size_t G_Q = G_GATE + (size_t)GROWS * 8192;
constexpr size_t G_CKV = G_Q + (size_t)GROWS * 1536 * 2;
constexpr size_t G_KN = G_CKV + (size_t)GKV * 256 * 2;
constexpr size_t G_K = G_KN + (size_t)GKV * 1024 * 2;
constexpr size_t G_VT = G_K + (size_t)GKV * 1536 * 2;
constexpr size_t G_RQ = G_VT + (size_t)1024 * GKV * 2;
constexpr size_t G_BR = G_RQ + (size_t)GROWS * 4;
constexpr size_t G_M = G_BR + (size_t)GROWS * 2560 * 2;
constexpr size_t G_SCR = G_M + (size_t)GROWS * 2048 * 2;
constexpr size_t G_END = G_SCR;
constexpr size_t WS_ACT = WS_G;
static_assert((size_t)TALL * DFF * 2 <= G_END, "act overlay");
constexpr size_t WS_XB = WS_G + G_END;
constexpr size_t WS_END = WS_XB + (size_t)TALL * DM * 2;
static_assert(WS_END <= (size_t)1073741824, "workspace");
static_assert(WS_H % 256 == 0 && WS_G % 256 == 0 && G_SCR % 256 == 0 && OFF_WFO % 256 == 0 && WS_XB % 256 == 0, "align");

constexpr int LDS_MISC = 131072;
constexpr int LDS_BYTES = 147456;

typedef __bf16 bf16x2_t __attribute__((ext_vector_type(2)));
__device__ __forceinline__ unsigned cvt_pk_bf16(float lo, float hi) { const f32x2 v = {lo, hi}; const bf16x2_t b = __builtin_convertvector(v, bf16x2_t); return __builtin_bit_cast(unsigned, b); }
__device__ __forceinline__ float bf_lo(unsigned w) { return __uint_as_float(w << 16); }
__device__ __forceinline__ float bf_hi(unsigned w) { return __uint_as_float(w & 0xffff0000u); }
__device__ __forceinline__ float bf1(bf16_t b) { return __uint_as_float(((unsigned)b) << 16); }
template <int CTRL> __device__ __forceinline__ float dpp_f(float v) { return __builtin_bit_cast(float, __builtin_amdgcn_update_dpp(0, __builtin_bit_cast(int, v), CTRL, 0xf, 0xf, true)); }
__device__ __forceinline__ float quad_sum(float v) { v += dpp_f<0xB1>(v); v += dpp_f<0x4E>(v); return v; }
__device__ __forceinline__ float wave_sum(float v) {
    v = quad_sum(v);
    v += dpp_f<0x141>(v);
    v += dpp_f<0x140>(v);
    { auto rr = __builtin_amdgcn_permlane16_swap(__float_as_uint(v), __float_as_uint(v), false, false); v = __uint_as_float(rr[0]) + __uint_as_float(rr[1]); }
    { auto rr = __builtin_amdgcn_permlane32_swap(__float_as_uint(v), __float_as_uint(v), false, false); v = __uint_as_float(rr[0]) + __uint_as_float(rr[1]); }
    return v;
}
__device__ __forceinline__ float sigmoidf_(float x) { return __builtin_amdgcn_rcpf(1.0f + __expf(-x)); }
__device__ __forceinline__ float gelu_tanh(float x) {
    const float y2 = 1.5957691216057308f * (x + 0.044715f * x * x * x);
    return x * __builtin_amdgcn_rcpf(1.0f + __expf(-y2));
}
__device__ __forceinline__ void load8(const bf16_t* p, float (&v)[8]) { const u32x4 w = *(const u32x4*)p; v[0] = bf_lo(w.x); v[1] = bf_hi(w.x); v[2] = bf_lo(w.y); v[3] = bf_hi(w.y); v[4] = bf_lo(w.z); v[5] = bf_hi(w.z); v[6] = bf_lo(w.w); v[7] = bf_hi(w.w); }
__device__ __forceinline__ void store8(bf16_t* p, const float (&v)[8]) { u32x4 w; w.x = cvt_pk_bf16(v[0], v[1]); w.y = cvt_pk_bf16(v[2], v[3]); w.z = cvt_pk_bf16(v[4], v[5]); w.w = cvt_pk_bf16(v[6], v[7]); *(u32x4*)p = w; }
#define LDS_WAIT() asm volatile("s_waitcnt lgkmcnt(0)" ::: "memory")
#define VM_WAIT() asm volatile("s_waitcnt vmcnt(0)" ::: "memory")

#define XB_TMO      128
#define XB_XCNT(j)  (256  + 64 * (j))
#define XB_XSUB(j)  (1280 + 64 * (j))
#define XB_XGEN(j)  (2304 + 64 * (j))
#define XB_TOP      3328
#define XB_TOPGEN   3392
#define XCD_BAR_WORDS 3456
#define XB_SPIN_CAP (1u << 18)
__device__ __forceinline__ unsigned xb_ld(unsigned* p)              { return __hip_atomic_load(p, __ATOMIC_RELAXED, __HIP_MEMORY_SCOPE_AGENT); }
__device__ __forceinline__ unsigned xb_add(unsigned* p, unsigned v) { return __hip_atomic_fetch_add(p, v, __ATOMIC_RELAXED, __HIP_MEMORY_SCOPE_AGENT); }
__device__ __forceinline__ unsigned xb_xcc_id() { return (unsigned)__builtin_amdgcn_s_getreg((3 << 11) | 20) & 0xFu; }
#define XB_SPIN(cond, bar) do { unsigned _sp = 0; while (cond) { __builtin_amdgcn_s_sleep(1); \
    if ((++_sp & 255u) == 0u) { if (xb_ld(&(bar)[XB_TMO])) break; if (_sp > XB_SPIN_CAP) { atomicAdd(&(bar)[XB_TMO], 1u); break; } } } } while (0)
struct XcdBarrier { unsigned* bar; unsigned x; volatile LAS unsigned* st; };
__device__ __forceinline__ XcdBarrier xcd_barrier_post(unsigned* bar, volatile LAS unsigned* st) {
    XcdBarrier b; b.bar = bar; b.x = xb_xcc_id(); b.st = st;
    if (threadIdx.x == 0) (void)xb_add(&bar[XB_XCNT(b.x)], 1u);
    return b;
}
__device__ __forceinline__ void xcd_barrier_complete(unsigned* bar, unsigned x, unsigned& nloc, unsigned& nx) {
    const unsigned G = gridDim.x * gridDim.y * gridDim.z;
    unsigned sum, cnt, mine, sp = 0u;
    for (;;) {
        sum = 0u; cnt = 0u; mine = 0u;
#pragma unroll
        for (unsigned j = 0; j < 16; ++j) { const unsigned c = xb_ld(&bar[XB_XCNT(j)]); sum += c; cnt += (c > 0u) ? 1u : 0u; mine = (j == x) ? c : mine; }
        if (sum == G) break;
        __builtin_amdgcn_s_sleep(1);
        if ((++sp & 255u) == 0u) { if (xb_ld(&bar[XB_TMO])) break; if (sp > XB_SPIN_CAP) { atomicAdd(&bar[XB_TMO], 1u); break; } }
    }
    nloc = mine > 0u ? mine : 1u; nx = cnt > 0u ? cnt : 1u;
}
__device__ __forceinline__ void xcd_barrier(const XcdBarrier& b) {
    asm volatile("s_waitcnt vmcnt(0)" ::: "memory");
    __syncthreads();
    if (threadIdx.x == 0) {
        unsigned* bar = b.bar;
        __builtin_amdgcn_s_waitcnt(0);
        unsigned nloc = b.st[0], nx = b.st[1];
        if (nloc == 0u) { xcd_barrier_complete(bar, b.x, nloc, nx); b.st[0] = nloc; b.st[1] = nx; }
        const unsigned old = xb_add(&bar[XB_XSUB(b.x)], 1u);
        const unsigned gen = old / nloc;
        if (old + 1u == (gen + 1u) * nloc) {
            __builtin_amdgcn_fence(__ATOMIC_RELEASE, "agent");
            asm volatile("s_waitcnt vmcnt(0)" ::: "memory");
            const unsigned og = xb_add(&bar[XB_TOP], 1u);
            const unsigned tg = og / nx;
            if (og + 1u == (tg + 1u) * nx) xb_add(&bar[XB_TOPGEN], 1u);
            else XB_SPIN(xb_ld(&bar[XB_TOPGEN]) == tg, bar);
            __builtin_amdgcn_fence(__ATOMIC_ACQUIRE, "agent");
            xb_add(&bar[XB_XGEN(b.x)], 1u);
            asm volatile("s_waitcnt vmcnt(0)" ::: "memory");
        } else {
            XB_SPIN(xb_ld(&bar[XB_XGEN(b.x)]) == gen, bar);
            __builtin_amdgcn_fence(__ATOMIC_ACQUIRE, "agent");
            asm volatile("s_waitcnt vmcnt(0)" ::: "memory");
        }
    }
    __syncthreads();
}

namespace pg8 {
constexpr int BM = 256, BK = 64, HALF = 128, HTB = HALF * BK * 2, STAGE_BYTES = 8 * HTB, NXCD = 8;
__host__ __device__ __forceinline__ int lds_byte(int r, int c) { const int st = (r >> 4) * 2 + (c >> 5), rr = r & 15, cc = c & 31, ob = rr * 64 + cc * 2; return st * 1024 + (ob ^ (((ob >> 9) & 1) << 5)); }
__host__ __device__ __forceinline__ void stage_rc(int b, int& R, int& C) { const int st = b / 1024, sb = b % 1024, swz = sb ^ (((sb >> 9) & 1) << 5); R = (st >> 1) * 16 + swz / 64; C = (st & 1) * 32 + (swz % 64) / 2; }
__host__ __device__ __forceinline__ int perm32(int rho) { const int n = rho >> 4, i = rho & 15; return 8 * (i >> 2) + 4 * n + (i & 3); }

struct Unit { int pm, pn, seg; };
struct Prob {
    const bf16_t* A; const bf16_t* Bt; int lda, ldb, K;
    __device__ __forceinline__ const char* abase(const Unit& u) const { return (const char*)(A + (size_t)u.pm * BM * lda); }
    __device__ __forceinline__ const char* bbase(const Unit& u) const { return (const char*)(Bt + (size_t)u.pn * BM * ldb); }
    __device__ __forceinline__ int ntiles(const Unit&) const { return K / BK; }
};
struct ProbSeg {
    const bf16_t* A; const bf16_t* Bt; int lda, ldb;
    __device__ __forceinline__ int koff(int s) const { return s == 0 ? 0 : 512 + 512 * s; }
    __device__ __forceinline__ const char* abase(const Unit& u) const { return (const char*)(A + (size_t)u.pm * BM * lda + koff(u.seg)); }
    __device__ __forceinline__ const char* bbase(const Unit& u) const { return (const char*)(Bt + (size_t)u.pn * BM * ldb + koff(u.seg)); }
    __device__ __forceinline__ int ntiles(const Unit& u) const { return u.seg == 0 ? 16 : 8; }
};
struct StaticOrder {
    int nM, nN, nwg, G, c, WGM;
    __device__ __forceinline__ void init(int M, int N, int G_, int c_, int wgm = 4) { nM = M / BM; nN = N / BM; nwg = nM * nN; G = G_; c = c_; WGM = wgm; }
    __device__ __forceinline__ bool tile(long L, Unit& u) const {
        if (L >= nwg) return false;
        int wgid = (int)L; { const int q = nwg / NXCD, r = nwg % NXCD, xcd = wgid % NXCD, off = wgid / NXCD; wgid = (xcd < r ? xcd * (q + 1) : r * (q + 1) + (xcd - r) * q) + off; }
        const int nig = WGM * nN, gid = wgid / nig, fm = gid * WGM, gsz = (nM - fm) < WGM ? (nM - fm) : WGM;
        u.pm = fm + ((wgid % nig) % gsz); u.pn = (wgid % nig) / gsz; return true;
    }
    __device__ __forceinline__ bool next(int i, Unit& u) const { u.seg = 0; return tile((long)i * G + c, u); }
};
struct SegOrder : StaticOrder {
    __device__ __forceinline__ bool next(int i, Unit& u) const { u.seg = i & 3; return tile((long)(i >> 2) * G + c, u); }
};

typedef f32x4 Acc[2][2][4][2];

template <class Epi, class Sched, class P>
__device__ __forceinline__ void gemm_phase(LAS unsigned char* lds, const P g, const Sched& S, const Epi& E) {
    int tid = threadIdx.x; asm volatile("" : "+v"(tid));
    const int wid = __builtin_amdgcn_readfirstlane(tid >> 6), lane = tid & 63, wr = wid >> 2, wc = wid & 3, fr = lane & 15, fq = lane >> 4;
    unsigned voffA[2], voffB[2];
#pragma unroll
    for (int i = 0; i < 2; ++i) { int R, C; stage_rc(tid * 16 + i * 8192, R, C); const int Rb = Epi::PERM ? ((R & ~31) + perm32(R & 31)) : R;
        voffA[i] = (unsigned)(R * g.lda + C) * 2u; voffB[i] = (unsigned)(Rb * g.ldb + C) * 2u; }
    const size_t kstep = (size_t)(BK * 2);
    const size_t hstepA = (size_t)HALF * g.lda * 2, hstepB = (size_t)HALF * g.ldb * 2;
    const unsigned ldsw = (unsigned)wid * 1024u;
    const int aoff = lds_byte(wr * 64 + fr, fq * 8), boff = lds_byte(wc * 32 + fr, fq * 8);
#define PG8_SA(b, h) (((b) * 2 + (h)) * HTB)
#define PG8_SB(b, h) ((4 + (b) * 2 + (h)) * HTB)
#define PG8_STAGE(bufoff, gbase, voff) do { _Pragma("unroll") for (int _i = 0; _i < 2; ++_i) \
        __builtin_amdgcn_global_load_lds((const unsigned*)((const char*)(gbase) + (voff)[_i]), (LAS unsigned*)(lds + (bufoff) + ldsw + _i * 8192), 16, 0, 0); } while (0)
#define PG8_LDA(dst, b, h) do { _Pragma("unroll") for (int m = 0; m < 4; ++m) _Pragma("unroll") for (int k = 0; k < 2; ++k) dst[m][k] = *(const LAS bf16x8*)(lds + PG8_SA(b, h) + aoff + m * 2048 + k * 1024); } while (0)
#define PG8_LDB(dst, b, h) do { _Pragma("unroll") for (int n = 0; n < 2; ++n) _Pragma("unroll") for (int k = 0; k < 2; ++k) dst[n][k] = *(const LAS bf16x8*)(lds + PG8_SB(b, h) + boff + n * 2048 + k * 1024); } while (0)
#define PG8_MMA(ai, bj, At, Bt) do { __builtin_amdgcn_s_setprio(1); _Pragma("unroll") for (int m = 0; m < 4; ++m) _Pragma("unroll") for (int n = 0; n < 2; ++n) _Pragma("unroll") for (int k = 0; k < 2; ++k) \
        acc[ai][bj][m][n] = __builtin_amdgcn_mfma_f32_16x16x32_bf16(Bt[n][k], At[m][k], acc[ai][bj][m][n], 0, 0, 0); __builtin_amdgcn_s_setprio(0); } while (0)
#define PG8_WAIT_V(n) asm volatile("s_waitcnt vmcnt(" #n ")" ::: "memory")
#define PG8_WAIT_L(n) asm volatile("s_waitcnt lgkmcnt(" #n ")" ::: "memory")
#define PG8_BAR __builtin_amdgcn_s_barrier()
#define PG8_SCHED __builtin_amdgcn_sched_barrier(0)
    Unit cur, nxt; int ui = 0;
    if (!S.next(0, cur)) return;
    Acc acc;
#pragma unroll
    for (int a = 0; a < 2; ++a)
#pragma unroll
        for (int b = 0; b < 2; ++b)
#pragma unroll
            for (int m = 0; m < 4; ++m)
#pragma unroll
                for (int n = 0; n < 2; ++n) acc[a][b][m][n] = (f32x4){0.f, 0.f, 0.f, 0.f};
    bf16x8 At[4][2], B0[2][2], B1[2][2];
    const char* cA = g.abase(cur); const char* cB = g.bbase(cur); int nt = g.ntiles(cur);
    PG8_STAGE(PG8_SB(0, 0), cB, voffB); PG8_STAGE(PG8_SB(0, 1), cB + hstepB, voffB); PG8_STAGE(PG8_SA(0, 0), cA, voffA); PG8_STAGE(PG8_SA(0, 1), cA + hstepA, voffA);
    if (wr == 1) PG8_BAR;
    PG8_WAIT_V(2); PG8_BAR;
    PG8_STAGE(PG8_SB(1, 0), cB + kstep, voffB); PG8_STAGE(PG8_SA(1, 0), cA + kstep, voffA); PG8_STAGE(PG8_SB(1, 1), cB + hstepB + kstep, voffB);
    PG8_WAIT_V(6); PG8_BAR;
    for (;;) {
        const bool has_next = S.next(ui + 1, nxt);
        const char* nA = has_next ? g.abase(nxt) : cA; const char* nB = has_next ? g.bbase(nxt) : cB;
        for (int t = 0; t < nt; t += 2) {
            const bool last = (t == nt - 2);
            const char* a1 = cA + (size_t)(t + 1) * kstep;
            const char* a2 = last ? nA : cA + (size_t)(t + 2) * kstep; const char* b2 = last ? nB : cB + (size_t)(t + 2) * kstep;
            const char* a3 = a2 + kstep; const char* b3 = b2 + kstep;
            PG8_LDB(B0, 0, 0); PG8_LDB(B1, 0, 1); PG8_SCHED; PG8_LDA(At, 0, 0); PG8_STAGE(PG8_SA(1, 1), a1 + hstepA, voffA);
            PG8_WAIT_V(8); PG8_WAIT_L(0); PG8_BAR; PG8_MMA(0, 0, At, B0); PG8_MMA(0, 1, At, B1); PG8_BAR; PG8_SCHED;
            PG8_LDA(At, 0, 1); PG8_STAGE(PG8_SB(0, 0), b2, voffB); PG8_STAGE(PG8_SB(0, 1), b2 + hstepB, voffB); PG8_STAGE(PG8_SA(0, 0), a2, voffA);
            PG8_WAIT_V(8); PG8_WAIT_L(0); PG8_BAR; PG8_MMA(1, 0, At, B0); PG8_MMA(1, 1, At, B1); PG8_BAR; PG8_SCHED;
            PG8_LDB(B0, 1, 0); PG8_LDB(B1, 1, 1); PG8_SCHED; PG8_LDA(At, 1, 0); PG8_STAGE(PG8_SA(0, 1), a2 + hstepA, voffA);
            PG8_WAIT_V(8); PG8_WAIT_L(0); PG8_BAR; PG8_MMA(0, 0, At, B0); PG8_MMA(0, 1, At, B1); PG8_BAR; PG8_SCHED;
            PG8_LDA(At, 1, 1); PG8_STAGE(PG8_SB(1, 0), b3, voffB); PG8_STAGE(PG8_SB(1, 1), b3 + hstepB, voffB); PG8_STAGE(PG8_SA(1, 0), a3, voffA);
            PG8_WAIT_V(8); PG8_WAIT_L(0); PG8_BAR; PG8_MMA(1, 0, At, B0); PG8_MMA(1, 1, At, B1); PG8_BAR; PG8_SCHED;
        }
        if (wr == 0) PG8_BAR;
        E(acc, cur, wr, wc, fr, fq);
        if (!has_next) break;
        if (!E.keep(cur)) {
#pragma unroll
        for (int a = 0; a < 2; ++a)
#pragma unroll
            for (int b = 0; b < 2; ++b)
#pragma unroll
                for (int m = 0; m < 4; ++m)
#pragma unroll
                    for (int n = 0; n < 2; ++n) acc[a][b][m][n] = (f32x4){0.f, 0.f, 0.f, 0.f};
        }
        cur = nxt; cA = nA; cB = nB; nt = g.ntiles(cur); ++ui;
        if (wr == 1) PG8_BAR;
    }
    PG8_WAIT_V(0);
    PG8_BAR;
#undef PG8_SA
#undef PG8_SB
#undef PG8_STAGE
#undef PG8_LDA
#undef PG8_LDB
#undef PG8_MMA
#undef PG8_WAIT_V
#undef PG8_WAIT_L
#undef PG8_BAR
#undef PG8_SCHED
}

struct EpiStore {
    static constexpr bool PERM = true;
    __device__ __forceinline__ bool keep(const Unit&) const { return false; }
    bf16_t* O; int ldc;
    __device__ __forceinline__ void operator()(const Acc& acc, const Unit& u, int wr, int wc, int fr, int fq) const {
        const int row0 = u.pm * BM + wr * 64 + fr, col0 = u.pn * BM + wc * 32 + 8 * fq;
#pragma unroll
        for (int ai = 0; ai < 2; ++ai)
#pragma unroll
            for (int m = 0; m < 4; ++m) { bf16_t* rowp = O + (size_t)(row0 + ai * HALF + m * 16) * ldc + col0;
#pragma unroll
                for (int bj = 0; bj < 2; ++bj) { const f32x4 v0 = acc[ai][bj][m][0], v1 = acc[ai][bj][m][1];
                    u32x4 w; w.x = cvt_pk_bf16(v0[0], v0[1]); w.y = cvt_pk_bf16(v0[2], v0[3]); w.z = cvt_pk_bf16(v1[0], v1[1]); w.w = cvt_pk_bf16(v1[2], v1[3]);
                    *(u32x4*)(rowp + bj * HALF) = w; } }
    }
};
struct EpiZ {
    static constexpr bool PERM = true;
    __device__ __forceinline__ bool keep(const Unit&) const { return false; }
    bf16_t* Z; bf16_t* G; const float* bgate;
    __device__ __forceinline__ void operator()(const Acc& acc, const Unit& u, int wr, int wc, int fr, int fq) const {
        const int row0 = u.pm * BM + wr * 64 + fr;
        if (u.pn < 16) {
            const int col0 = u.pn * BM + wc * 32 + 8 * fq;
#pragma unroll
            for (int ai = 0; ai < 2; ++ai)
#pragma unroll
                for (int m = 0; m < 4; ++m) { bf16_t* rowp = Z + (size_t)(row0 + ai * HALF + m * 16) * 4096 + col0;
#pragma unroll
                    for (int bj = 0; bj < 2; ++bj) { const f32x4 v0 = acc[ai][bj][m][0], v1 = acc[ai][bj][m][1];
                        u32x4 w; w.x = cvt_pk_bf16(v0[0], v0[1]); w.y = cvt_pk_bf16(v0[2], v0[3]); w.z = cvt_pk_bf16(v1[0], v1[1]); w.w = cvt_pk_bf16(v1[2], v1[3]);
                        *(u32x4*)(rowp + bj * HALF) = w; } }
        } else {
            const int col0 = (u.pn - 16) * BM + wc * 32 + 8 * fq;
            f32x4 bv[2][2];
#pragma unroll
            for (int bj = 0; bj < 2; ++bj)
#pragma unroll
                for (int n = 0; n < 2; ++n) bv[bj][n] = *(const f32x4*)(bgate + col0 + bj * HALF + 4 * n) * (-1.44269504f);
            unsigned char* Gq = (unsigned char*)G + ((size_t)(u.pm * 4 + ((u.pn - 16) >> 3)) * 8 + ((u.pn - 16) & 7)) * 65536 + (size_t)(wr * 4 + wc) * 8192 + (size_t)(fq * 16 + fr) * 16;
#pragma unroll
            for (int ai = 0; ai < 2; ++ai)
#pragma unroll
                for (int m = 0; m < 4; ++m) {
                    unsigned wv[4] = {0u, 0u, 0u, 0u};
#pragma unroll
                    for (int bj = 0; bj < 2; ++bj)
#pragma unroll
                        for (int n = 0; n < 2; ++n) { const f32x4 a4 = acc[ai][bj][m][n], b4 = bv[bj][n];
#pragma unroll
                            for (int j = 0; j < 4; ++j) {
                                const float e = __builtin_amdgcn_exp2f(__builtin_fmaf(a4[j], -1.44269504f, b4[j]));
                                wv[bj * 2 + n] = __builtin_amdgcn_cvt_pk_u8_f32(fmaxf(__builtin_amdgcn_rcpf(__builtin_fmaf(e, 1.0f / 255.0f, 1.0f / 255.0f)), 1.0f), j, wv[bj * 2 + n]); } }
                    u32x4 w; w.x = wv[0]; w.y = wv[1]; w.z = wv[2]; w.w = wv[3];
                    *(u32x4*)(Gq + (ai * 4 + m) * 1024) = w; }
        }
    }
};
struct EpiSwiglu {
    static constexpr bool PERM = true;
    __device__ __forceinline__ bool keep(const Unit&) const { return false; }
    bf16_t* O;
    __device__ __forceinline__ void operator()(const Acc& acc, const Unit& u, int wr, int wc, int fr, int fq) const {
        const int row0 = u.pm * BM + wr * 64 + fr, col0 = u.pn * HALF + wc * 32 + 8 * fq;
#pragma unroll
        for (int ai = 0; ai < 2; ++ai)
#pragma unroll
            for (int m = 0; m < 4; ++m) { bf16_t* rowp = O + (size_t)(row0 + ai * HALF + m * 16) * DFF + col0;
                f32x4 v0, v1;
#pragma unroll
                for (int j = 0; j < 4; ++j) { const float g0 = acc[ai][0][m][0][j], g1 = acc[ai][0][m][1][j];
                    v0[j] = g0 * sigmoidf_(g0) * acc[ai][1][m][0][j]; v1[j] = g1 * sigmoidf_(g1) * acc[ai][1][m][1][j]; }
                u32x4 w; w.x = cvt_pk_bf16(v0[0], v0[1]); w.y = cvt_pk_bf16(v0[2], v0[3]); w.z = cvt_pk_bf16(v1[0], v1[1]); w.w = cvt_pk_bf16(v1[2], v1[3]);
                *(u32x4*)rowp = w; }
    }
};
struct EpiResid {
    static constexpr bool PERM = true;
    __device__ __forceinline__ bool keep(const Unit&) const { return false; }
    const float* xin_ctx; const float* xin_lat; bf16_t* xb; float* yout; const float* modl; int gidx; int grow0;
    __device__ __forceinline__ void operator()(const Acc& acc, const Unit& u, int wr, int wc, int fr, int fq) const {
        const int prow = grow0 + u.pm * BM;
        const int cond = prow < TCTX ? 0 : 1 + ((prow - TCTX) >> 12);
        const float* gv = modl + (size_t)cond * 12288 + gidx * DM;
        const int rl0 = wr * 64 + fr, col0 = u.pn * BM + wc * 32 + 8 * fq;
        f32x4 g4[2][2];
#pragma unroll
        for (int bj = 0; bj < 2; ++bj)
#pragma unroll
            for (int n = 0; n < 2; ++n) g4[bj][n] = *(const f32x4*)(gv + col0 + bj * HALF + n * 4);
        bf16_t* xo = xb + (size_t)prow * DM;
        if (xin_ctx) {
            const float* xin = prow < TCTX ? xin_ctx + (size_t)prow * DM : xin_lat + (size_t)(prow - TCTX) * DM;
#pragma unroll
            for (int ai = 0; ai < 2; ++ai) {
#pragma unroll
                for (int m = 0; m < 4; ++m) { const size_t off = (size_t)(rl0 + ai * HALF + m * 16) * DM + col0;
#pragma unroll
                    for (int bj = 0; bj < 2; ++bj) { const f32x4 x0 = *(const f32x4*)(xin + off + bj * HALF), x1 = *(const f32x4*)(xin + off + bj * HALF + 4);
                        const f32x4 r0 = x0 + g4[bj][0] * acc[ai][bj][m][0], r1 = x1 + g4[bj][1] * acc[ai][bj][m][1];
                        u32x4 w; w.x = cvt_pk_bf16(r0[0], r0[1]); w.y = cvt_pk_bf16(r0[2], r0[3]); w.z = cvt_pk_bf16(r1[0], r1[1]); w.w = cvt_pk_bf16(r1[2], r1[3]);
                        *(u32x4*)(xo + off + bj * HALF) = w; } }
                asm volatile("" ::: "memory"); }
        } else {
            u32x4 xw[4][2];
#pragma unroll
            for (int m = 0; m < 4; ++m)
#pragma unroll
                for (int bj = 0; bj < 2; ++bj) xw[m][bj] = *(const u32x4*)(xo + (size_t)(rl0 + m * 16) * DM + col0 + bj * HALF);
            float* yo = yout ? yout + (size_t)prow * DM : nullptr;
#pragma unroll
            for (int ai = 0; ai < 2; ++ai) {
#pragma unroll
                for (int m = 0; m < 4; ++m) { const size_t off = (size_t)(rl0 + ai * HALF + m * 16) * DM + col0;
#pragma unroll
                    for (int bj = 0; bj < 2; ++bj) { const u32x4 w4 = xw[m][bj];
                        if (ai == 0) xw[m][bj] = *(const u32x4*)(xo + off + (size_t)HALF * DM + bj * HALF);
                        const f32x4 x0 = {bf_lo(w4.x), bf_hi(w4.x), bf_lo(w4.y), bf_hi(w4.y)}, x1 = {bf_lo(w4.z), bf_hi(w4.z), bf_lo(w4.w), bf_hi(w4.w)};
                        const f32x4 r0 = x0 + g4[bj][0] * acc[ai][bj][m][0], r1 = x1 + g4[bj][1] * acc[ai][bj][m][1];
                        if (yo) { *(f32x4*)(yo + off + bj * HALF) = r0; *(f32x4*)(yo + off + bj * HALF + 4) = r1; }
                        else { u32x4 w; w.x = cvt_pk_bf16(r0[0], r0[1]); w.y = cvt_pk_bf16(r0[2], r0[3]); w.z = cvt_pk_bf16(r1[0], r1[1]); w.w = cvt_pk_bf16(r1[2], r1[3]);
                            *(u32x4*)(xo + off + bj * HALF) = w; } } } }
        }
    }
};
struct EpiMerge {
    static constexpr bool PERM = true;
    const unsigned char* G; bf16_t* Mo;
    __device__ __forceinline__ bool keep(const Unit& u) const { return u.seg != 3; }
    __device__ __forceinline__ void operator()(Acc& acc, const Unit& u, int wr, int wc, int fr, int fq) const {
        const int seg = u.seg;
        const int urow = u.pm * BM + wr * 64, ucol = u.pn * BM + wc * 32;
        const char* gbase = (const char*)(G + ((size_t)(u.pm * 4 + seg) * 8 + u.pn) * 65536 + (size_t)(wr * 4 + wc) * 8192);
        char* mbase = (char*)(Mo + (size_t)urow * DM + ucol);
        unsigned goff = (unsigned)(fq * 16 + fr) * 16u, moff = (unsigned)(fr * DM + 8 * fq) * 2u;
        asm volatile("" : "+v"(goff), "+v"(moff));
        u32x4 gw[8], hw[8];
#pragma unroll
        for (int q = 0; q < 8; ++q) { gw[q] = *(const u32x4*)(gbase + q * 1024 + goff);
            if (seg != 3) hw[q] = *(const u32x4*)(gbase + 8 * 65536 + q * 1024 + goff); else hw[q] = (u32x4){0u, 0u, 0u, 0u}; }
#pragma unroll
        for (int ai = 0; ai < 2; ++ai) {
#pragma unroll
            for (int m = 0; m < 4; ++m) {
                const u32x4 g4 = gw[ai * 4 + m], h4 = hw[ai * 4 + m];
                const unsigned gq[4] = {g4.x, g4.y, g4.z, g4.w}, hq[4] = {h4.x, h4.y, h4.z, h4.w};
#pragma unroll
                for (int bj = 0; bj < 2; ++bj) {
                    float f[8];
#pragma unroll
                    for (int n = 0; n < 2; ++n) { const unsigned gx = gq[bj * 2 + n], hx = hq[bj * 2 + n];
                        f[4 * n + 0] = (float)(gx & 255u); f[4 * n + 1] = (float)((gx >> 8) & 255u); f[4 * n + 2] = (float)((gx >> 16) & 255u); f[4 * n + 3] = (float)(gx >> 24);
                        if (seg != 3) { f[4 * n + 0] *= __builtin_amdgcn_rcpf((float)(hx & 255u)); f[4 * n + 1] *= __builtin_amdgcn_rcpf((float)((hx >> 8) & 255u));
                            f[4 * n + 2] *= __builtin_amdgcn_rcpf((float)((hx >> 16) & 255u)); f[4 * n + 3] *= __builtin_amdgcn_rcpf((float)(hx >> 24)); }
                        else { f[4 * n + 0] *= (1.0f / 255.0f); f[4 * n + 1] *= (1.0f / 255.0f); f[4 * n + 2] *= (1.0f / 255.0f); f[4 * n + 3] *= (1.0f / 255.0f); } }
                    f32x4 v0 = acc[ai][bj][m][0], v1 = acc[ai][bj][m][1];
                    v0[0] *= f[0]; v0[1] *= f[1]; v0[2] *= f[2]; v0[3] *= f[3]; v1[0] *= f[4]; v1[1] *= f[5]; v1[2] *= f[6]; v1[3] *= f[7];
                    if (seg != 3) { acc[ai][bj][m][0] = v0; acc[ai][bj][m][1] = v1; }
                    else { u32x4 w; w.x = cvt_pk_bf16(v0[0], v0[1]); w.y = cvt_pk_bf16(v0[2], v0[3]); w.z = cvt_pk_bf16(v1[0], v1[1]); w.w = cvt_pk_bf16(v1[2], v1[3]);
                        *(u32x4*)(mbase + (size_t)(ai * HALF + m * 16) * (DM * 2) + bj * 256 + moff) = w; } } }
            asm volatile("" ::: "memory"); }
    }
};
}

struct Args { const float* in[31]; float* out; unsigned char* ws; int step_lo, step_hi; };
enum { I_XP = 0, I_XS, I_CCKV, I_CKPE, I_C, I_CCTX, I_WMOD, I_BMOD, I_NMIX, I_NFFN, I_WIN, I_BGATE, I_QAN, I_KVAN, I_WUQ, I_WUKV, I_QN, I_KN,
       I_WPOOL, I_PSCALE, I_SGUN, I_WSP, I_BSP, I_CONVW, I_WBA, I_WBP, I_WBS, I_WBC, I_WOUT, I_WFI, I_WFO };

struct Grp { int row0, rows, nseq, L, C, tkv; };
__device__ __forceinline__ Grp grp_of(int g) {
    Grp r;
    if (g == 0) { r.row0 = 0; r.rows = 4096; r.nseq = 16; r.L = 256; r.C = 0; r.tkv = 4096; }
    else { r.row0 = TCTX + (g - 1) * 16384; r.rows = 16384; r.nseq = 4; r.L = 4096; r.C = 256; r.tkv = 17408; }
    return r;
}

struct Frame {
    LAS unsigned char* lds;
    int tid, lane, wave, bx, G, gw, ngw;
    const float* const* in; float* out; unsigned char* ws;
};

__device__ __forceinline__ Frame fresh(const Frame& F0) {
    Frame F = F0;
    asm volatile("" : "+v"(F.tid));
    int z; asm volatile("s_mov_b32 %0, 0" : "=s"(z));
    F.in = F0.in + z; F.out = F0.out + z; F.ws = F0.ws + z; F.bx = F0.bx + z;
    F.lane = F.tid & 63; F.wave = __builtin_amdgcn_readfirstlane(F.tid >> 6);
    F.gw = F.bx * NWAVE + F.wave; F.ngw = F.G * NWAVE;
    return F;
}
#define LAUNDER_S(x) do { int z_; asm volatile("s_mov_b32 %0, 0" : "=s"(z_)); (x) += z_; } while (0)
struct TrDesc { const float* W; const float* ks; bf16_t* dst; int ldw, k0, n0, ldd; };
__device__ __forceinline__ void tr_load(const TrDesc& d, f32x4 (&tv)[8], int lane) {
#pragma unroll
    for (int i = 0; i < 8; ++i) tv[i] = *(const f32x4*)(d.W + (size_t)(d.k0 + 8 * i + (lane >> 3)) * d.ldw + d.n0 + 4 * (lane & 7));
}
__device__ __forceinline__ void tr_finish(const TrDesc& d, const f32x4 (&tv)[8], LAS float* scr, int lane) {
#pragma unroll
    for (int i = 0; i < 8; ++i) { const int kk = 8 * i + (lane >> 3); f32x4 v = tv[i]; if (d.ks) v = v * d.ks[d.k0 + kk];
        LAS float* q = scr + kk * 33 + 4 * (lane & 7); q[0] = v[0]; q[1] = v[1]; q[2] = v[2]; q[3] = v[3]; }
    LDS_WAIT(); asm volatile("" ::: "memory");
    const int c = lane & 7;
#pragma unroll
    for (int j = 0; j < 4; ++j) { const int n = (lane >> 3) + 8 * j; const LAS float* s = scr + (8 * c) * 33 + n;
        u32x4 o; o.x = cvt_pk_bf16(s[0 * 33], s[1 * 33]); o.y = cvt_pk_bf16(s[2 * 33], s[3 * 33]); o.z = cvt_pk_bf16(s[4 * 33], s[5 * 33]); o.w = cvt_pk_bf16(s[6 * 33], s[7 * 33]);
        *(u32x4*)(d.dst + (size_t)n * d.ldd + d.k0 + 8 * c) = o; }
    LDS_WAIT(); asm volatile("" ::: "memory");
}
__device__ __forceinline__ TrDesc tr_desc(int r, int l, const float* const* in, unsigned char* wl) {
    constexpr int IA = 32 * 385, IB = 12 * 48, IC = 4 * 64, ID = 16 * 64, IE = 8 * 64, IF_ = 8 * 64, IG = 32 * 64, IH = 32 * 352;
    TrDesc d; d.ks = nullptr;
    if (r < IA) { const int kb = r / 385, sg = r % 385; d.W = in[I_WIN] + (size_t)l * DM * NINW; d.ldw = NINW; d.k0 = 64 * kb; d.n0 = 32 * sg; d.ldd = 2048;
        d.dst = sg < 32 ? (bf16_t*)(wl + OFF_WIN) + (size_t)(32 * sg) * 2048 : sg == 32 ? (bf16_t*)(wl + OFF_WKPE) : (bf16_t*)(wl + OFF_WIN) + (size_t)(32 * (sg - 1)) * 2048; return d; } r -= IA;
    if (r < IB) { const int kb = r / 48, sg = r % 48; d.W = in[I_WUQ] + (size_t)l * QLORA * 1536; d.ldw = 1536; d.k0 = 64 * kb; d.n0 = 32 * sg; d.ldd = 768; d.ks = in[I_QAN] + l * QLORA;
        d.dst = (bf16_t*)(wl + OFF_WUQ) + (size_t)(32 * sg) * 768; return d; } r -= IB;
    if (r < IC) { const int kb = r / 64, sg = r % 64, hh = sg >> 2, part = sg & 3; d.W = in[I_WUKV] + (size_t)l * KVL * 2048; d.ldw = 2048; d.k0 = 64 * kb; d.n0 = 32 * sg; d.ldd = 256;
        d.dst = part < 2 ? (bf16_t*)(wl + OFF_WUK) + (size_t)(hh * 64 + 32 * part) * 256 : (bf16_t*)(wl + OFF_WUV) + (size_t)(hh * 64 + 32 * (part - 2)) * 256; return d; } r -= IC;
    if (r < ID) { const int kb = r / 64, sg = r % 64; d.W = in[I_WBA] + (size_t)l * 1024 * DM; d.ldw = DM; d.k0 = 64 * kb; d.n0 = 32 * sg; d.ldd = 2560; d.dst = (bf16_t*)(wl + OFF_WBR) + (size_t)(32 * sg) * 2560; return d; } r -= ID;
    if (r < IE) { const int kb = r / 64, sg = r % 64; d.W = in[I_WBS] + (size_t)l * 512 * DM; d.ldw = DM; d.k0 = 64 * kb; d.n0 = 32 * sg; d.ldd = 2560; d.dst = (bf16_t*)(wl + OFF_WBR) + (size_t)(32 * sg) * 2560 + 1536; return d; } r -= IE;
    if (r < IF_) { const int kb = r / 64, sg = r % 64; d.W = in[I_WBC] + (size_t)l * 512 * DM; d.ldw = DM; d.k0 = 64 * kb; d.n0 = 32 * sg; d.ldd = 2560; d.dst = (bf16_t*)(wl + OFF_WBR) + (size_t)(32 * sg) * 2560 + 2048; return d; } r -= IF_;
    if (r < IG) { const int kb = r / 64, sg = r % 64; d.W = in[I_WOUT] + (size_t)l * DM * DM; d.ldw = DM; d.k0 = 64 * kb; d.n0 = 32 * sg; d.ldd = 2048; d.dst = (bf16_t*)(wl + OFF_WOUT) + (size_t)(32 * sg) * 2048; return d; } r -= IG;
    if (r < IH) { const int kb = r / 352, sg = r % 352; const int s2 = sg < 176 ? sg : sg - 176; const int drow = 256 * (s2 >> 2) + 32 * (s2 & 3) + (sg < 176 ? 0 : 128);
        d.W = in[I_WFI] + (size_t)l * DM * 2 * DFF; d.ldw = 2 * DFF; d.k0 = 64 * kb; d.n0 = 32 * sg; d.ldd = 2048; d.dst = (bf16_t*)(wl + OFF_WFI) + (size_t)drow * 2048; return d; } r -= IH;
    { const int kb = r / 64, sg = r % 64; d.W = in[I_WFO] + (size_t)l * DFF * DM; d.ldw = DM; d.k0 = 64 * kb; d.n0 = 32 * sg; d.ldd = DFF; d.dst = (bf16_t*)(wl + OFF_WFO) + (size_t)(32 * sg) * DFF; return d; }
}
__device__ __forceinline__ void p0_prologue(Frame& F, int lcv) {
    if (lcv == 0)
    {
        LAS float* sc = (LAS float*)F.lds;
        LAS float* red = (LAS float*)(F.lds + 81920);
        for (int idx = F.tid; idx < NCOND * DM; idx += NTHR) { const int ci = idx >> 11, k = idx & 2047;
            const float v = ci == 0 ? F.in[I_CCTX][k] : F.in[I_C][(ci - 1) * DM + k];
            sc[k * 10 + ci] = v * sigmoidf_(v); }
        __syncthreads();
        for (int it = F.bx; it < NLAYER * 96; it += F.G) {
            const int l = it / 96, jb = it % 96, col = jb * 128 + 2 * F.lane;
            const float* wp = F.in[I_WMOD] + (size_t)l * DM * 12288 + col;
            float a[9][2];
#pragma unroll
            for (int i = 0; i < 9; ++i) { a[i][0] = 0.f; a[i][1] = 0.f; }
            const int kb = F.wave * 256;
#pragma unroll 16
            for (int k = kb; k < kb + 256; ++k) { const f32x2 wv = *(const f32x2*)(wp + (size_t)k * 12288);
                const LAS f32x2* s2 = (const LAS f32x2*)(sc + k * 10);
                const f32x2 s0 = s2[0], s1 = s2[1], s2_ = s2[2], s3 = s2[3], s4 = s2[4];
                a[0][0] += wv.x * s0.x; a[0][1] += wv.y * s0.x; a[1][0] += wv.x * s0.y; a[1][1] += wv.y * s0.y;
                a[2][0] += wv.x * s1.x; a[2][1] += wv.y * s1.x; a[3][0] += wv.x * s1.y; a[3][1] += wv.y * s1.y;
                a[4][0] += wv.x * s2_.x; a[4][1] += wv.y * s2_.x; a[5][0] += wv.x * s2_.y; a[5][1] += wv.y * s2_.y;
                a[6][0] += wv.x * s3.x; a[6][1] += wv.y * s3.x; a[7][0] += wv.x * s3.y; a[7][1] += wv.y * s3.y;
                a[8][0] += wv.x * s4.x; a[8][1] += wv.y * s4.x; }
#pragma unroll
            for (int i = 0; i < 9; ++i) *(LAS f32x2*)(red + (F.wave * 9 + i) * 128 + 2 * F.lane) = (f32x2){a[i][0], a[i][1]};
            __syncthreads();
            for (int o = F.tid; o < 1152; o += NTHR) { const int i = o >> 7, ln = o & 127; float s = 0.f;
#pragma unroll
                for (int w = 0; w < 8; ++w) s += red[(w * 9 + i) * 128 + ln];
                const int c2 = jb * 128 + ln;
                ((float*)(F.ws + WS_MOD))[((size_t)l * NCOND + i) * 12288 + c2] = s + F.in[I_BMOD][(size_t)l * 12288 + c2]; }
            __syncthreads();
        }
    }
    __syncthreads();
    {
        LAS float* scr = (LAS float*)(F.lds + F.wave * 16384);
        constexpr int NIT = 32 * 385 + 12 * 48 + 4 * 64 + 16 * 64 + 8 * 64 + 8 * 64 + 32 * 64 + 32 * 352 + 88 * 64;
        unsigned char* wl = F.ws + WS_W0;
        int it = F.gw;
        TrDesc cur; f32x4 tv[8];
        if (it < NIT) { cur = tr_desc(it, lcv, F.in, wl); tr_load(cur, tv, F.lane); }
        for (; it < NIT; it += F.ngw) {
            TrDesc nxt = cur; f32x4 tn[8];
            const bool hn = it + F.ngw < NIT;
            if (hn) { nxt = tr_desc(it + F.ngw, lcv, F.in, wl); tr_load(nxt, tn, F.lane); }
            tr_finish(cur, tv, scr, F.lane);
            if (hn) {
#pragma unroll
                for (int i = 0; i < 8; ++i) tv[i] = tn[i];
                cur = nxt; }
        }
    }
    {
        int ngt = F.G * NTHR; LAUNDER_S(ngt);
        const int gt = F.bx * NTHR + F.tid;
        for (int e = gt; e < 65536; e += ngt) { const int l = lcv;
            ((bf16_t*)(F.ws + WS_W0 + OFF_WSP))[e] = (bf16_t)(cvt_pk_bf16(F.in[I_WSP][l * 65536 + e], 0.f) & 0xffffu); }
    }
    {
        LAS float* Al = (LAS float*)F.lds;
        LAS float* Bl = (LAS float*)(F.lds + 65536);
        for (int it = F.bx; it < 4 * 32; it += F.G) {
            const int l = lcv, g = (it >> 5) & 3, nb = it & 31;
            const float* wp = F.in[I_WPOOL] + (size_t)(l * 4 + g) * 128 * 128;
            const float* ps = F.in[I_PSCALE] + l * 512 + g * 128;
            const float* wb = F.in[I_WBP] + ((size_t)l * 512 + g * 128) * DM + nb * 64;
            __syncthreads();
#pragma unroll
            for (int q = 0; q < 8; ++q) { const int i4 = F.tid + NTHR * q, k = i4 >> 5, j4 = (i4 & 31) * 4;
                *(LAS f32x4*)(Al + k * 128 + j4) = *(const f32x4*)(wp + k * 128 + j4) * *(const f32x4*)(ps + j4); }
#pragma unroll
            for (int q = 0; q < 4; ++q) { const int i4 = F.tid + NTHR * q, j = i4 >> 4, n4 = (i4 & 15) * 4;
                *(LAS f32x4*)(Bl + j * 64 + n4) = *(const f32x4*)(wb + (size_t)j * DM + n4); }
            __syncthreads();
            const int n = F.tid & 63, k0 = (F.tid >> 6) * 16;
            float acc[16];
#pragma unroll
            for (int kk = 0; kk < 16; ++kk) acc[kk] = 0.f;
            for (int j4 = 0; j4 < 32; ++j4) {
                const float b0 = Bl[(4 * j4 + 0) * 64 + n], b1 = Bl[(4 * j4 + 1) * 64 + n], b2 = Bl[(4 * j4 + 2) * 64 + n], b3 = Bl[(4 * j4 + 3) * 64 + n];
#pragma unroll
                for (int kk = 0; kk < 16; ++kk) { const f32x4 a4 = *(const LAS f32x4*)(Al + (k0 + kk) * 128 + 4 * j4); acc[kk] += (a4[0] * b0 + a4[1] * b1) + (a4[2] * b2 + a4[3] * b3); } }
            bf16_t* dst = (bf16_t*)(F.ws + WS_W0 + OFF_WBR) + (size_t)(nb * 64 + n) * 2560 + 1024 + g * 128 + k0;
            float o0[8], o1[8];
#pragma unroll
            for (int kk = 0; kk < 8; ++kk) { o0[kk] = acc[kk]; o1[kk] = acc[8 + kk]; }
            store8(dst, o0); store8(dst + 8, o1);
        }
        __syncthreads();
    }
}

template <bool KPE, bool XBF>
__device__ __forceinline__ void thin_norm(Frame& F, int l, const float* xc, const float* xl, const float* nw, int ish, int isc) {
    constexpr int HL = 4112;
    LAS unsigned char* hl = F.lds; LAS float* red = (LAS float*)(F.lds + 66048);
    const float* modl = (const float*)(F.ws + WS_MOD) + (size_t)l * NCOND * 12288;
    bf16_t* H = (bf16_t*)(F.ws + WS_H);
    const bf16_t* XB = (const bf16_t*)(F.ws + WS_XB);
    const bf16_t* WK = (const bf16_t*)(F.ws + WS_W0 + OFF_WKPE);
    bf16_t* KP = (bf16_t*)(F.ws + WS_KPE);
    const int nitems = TALL / 16, per = (nitems + F.G - 1) / F.G, it_lo = F.bx * per, it_hi = (it_lo + per < nitems) ? it_lo + per : nitems;
    f32x4 A[8], B[8]; int cond_cur = -1;
    f32x4 vn[8]; u32x4 vb[4];
#define TN_LOAD(row_) do { if (XBF) { const bf16_t* xr_ = XB + (size_t)(row_) * DM + 8 * F.lane; \
            _Pragma("unroll") for (int j = 0; j < 4; ++j) vb[j] = *(const u32x4*)(xr_ + 512 * j); } \
        else { const float* xr_ = ((row_) < TCTX ? xc + (size_t)(row_) * DM : xl + (size_t)((row_) - TCTX) * DM) + 8 * F.lane; \
            _Pragma("unroll") for (int j = 0; j < 4; ++j) { vn[2 * j] = *(const f32x4*)(xr_ + 512 * j); vn[2 * j + 1] = *(const f32x4*)(xr_ + 512 * j + 4); } } } while (0)
    if (it_lo < it_hi) TN_LOAD(it_lo * 16 + 2 * F.wave);
    for (int it = it_lo; it < it_hi; ++it) {
        const int prow = it * 16;
        const int cond = prow < TCTX ? 0 : 1 + ((prow - TCTX) >> 12);
        if (cond != cond_cur) { cond_cur = cond;
            const float* sh = modl + (size_t)cond * 12288 + ish * DM; const float* sc = modl + (size_t)cond * 12288 + isc * DM;
#pragma unroll
            for (int j = 0; j < 8; ++j) { const int c = 8 * F.lane + 512 * (j >> 1) + 4 * (j & 1); const f32x4 w4 = *(const f32x4*)(nw + c), s4 = *(const f32x4*)(sc + c); A[j] = w4 * (1.0f + s4); B[j] = *(const f32x4*)(sh + c); } }
#pragma unroll
        for (int rr = 0; rr < 2; ++rr) {
            const int rl = 2 * F.wave + rr, row = prow + rl; float ss = 0.f;
            f32x4 v[8];
            if (XBF) {
#pragma unroll
                for (int j = 0; j < 4; ++j) { const u32x4 w = vb[j]; v[2 * j] = (f32x4){bf_lo(w.x), bf_hi(w.x), bf_lo(w.y), bf_hi(w.y)}; v[2 * j + 1] = (f32x4){bf_lo(w.z), bf_hi(w.z), bf_lo(w.w), bf_hi(w.w)}; }
            } else {
#pragma unroll
                for (int j = 0; j < 8; ++j) v[j] = vn[j];
            }
            if (rr == 0) TN_LOAD(row + 1); else if (it + 1 < it_hi) TN_LOAD(row + 15);
#pragma unroll
            for (int j = 0; j < 8; ++j) ss += (v[j][0] * v[j][0] + v[j][1] * v[j][1]) + (v[j][2] * v[j][2] + v[j][3] * v[j][3]);
            const float rstd = rsqrtf(wave_sum(ss) * (1.0f / DM) + EPS);
#pragma unroll
            for (int j = 0; j < 4; ++j) { const f32x4 h0 = v[2 * j] * rstd * A[2 * j] + B[2 * j], h1 = v[2 * j + 1] * rstd * A[2 * j + 1] + B[2 * j + 1];
                u32x4 w; w.x = cvt_pk_bf16(h0[0], h0[1]); w.y = cvt_pk_bf16(h0[2], h0[3]); w.z = cvt_pk_bf16(h1[0], h1[1]); w.w = cvt_pk_bf16(h1[2], h1[3]);
                *(u32x4*)(H + (size_t)row * DM + 8 * F.lane + 512 * j) = w;
                if (KPE) *(LAS u32x4*)(hl + rl * HL + (8 * F.lane + 512 * j) * 2) = w; }
        }
        if (KPE) {
            __syncthreads();
            const int fr = F.lane & 15, fq = F.lane >> 4;
            f32x4 a0 = {0.f, 0.f, 0.f, 0.f}, a1 = {0.f, 0.f, 0.f, 0.f};
#pragma unroll
            for (int ks = 0; ks < 8; ++ks) { const int k = 256 * F.wave + 32 * ks + 8 * fq;
                const bf16x8 af = *(const LAS bf16x8*)(hl + fr * HL + k * 2);
                const bf16x8 b0 = *(const bf16x8*)(WK + (size_t)fr * DM + k), b1 = *(const bf16x8*)(WK + (size_t)(16 + fr) * DM + k);
                a0 = __builtin_amdgcn_mfma_f32_16x16x32_bf16(b0, af, a0, 0, 0, 0); a1 = __builtin_amdgcn_mfma_f32_16x16x32_bf16(b1, af, a1, 0, 0, 0); }
            *(LAS f32x4*)(red + F.wave * 512 + fr * 32 + 4 * fq) = a0; *(LAS f32x4*)(red + F.wave * 512 + fr * 32 + 16 + 4 * fq) = a1;
            __syncthreads();
            { const int rl = F.tid >> 5, n = F.tid & 31; float s = 0.f;
#pragma unroll
                for (int w = 0; w < 8; ++w) s += red[w * 512 + rl * 32 + n];
                const int row = prow + rl;
                KP[(size_t)row * 32 + n] = (bf16_t)(cvt_pk_bf16(s, 0.f) & 0xffffu);
                if (row < TCTX) { const int b = row >> 8, sidx = row & 255; F.out[(size_t)TALL * DM + (size_t)16 * 2 * 256 * 256 + ((size_t)(b * 2 + l) * 256 + sidx) * 32 + n] = s; } }
            __syncthreads();
        }
    }
#undef TN_LOAD
}

__device__ __forceinline__ void thin_b(Frame& F, int l, int g) {
    const Grp gr = grp_of(g);
    unsigned char* gb = F.ws + WS_G;
    const bf16_t* Z = (const bf16_t*)(gb + G_Z); bf16_t* CKV = (bf16_t*)(gb + G_CKV); bf16_t* BR = (bf16_t*)(gb + G_BR);
    const float* kvan = F.in[I_KVAN] + l * KVL; const float* convw = F.in[I_CONVW] + l * 3 * 512;
    const int lane = F.lane;
    for (int r = gr.rows + F.gw; r < gr.tkv; r += F.ngw) {
        const int ci = r - gr.rows, sq = ci >> 8, p = ci & 255, b = 4 * (g - 1) + sq;
        const f32x4 v = *(const f32x4*)(F.in[I_CCKV] + (((size_t)b * 2 + l) * 256 + p) * 256 + 4 * lane);
        u32x2 w; w.x = cvt_pk_bf16(v[0], v[1]); w.y = cvt_pk_bf16(v[2], v[3]); *(u32x2*)(CKV + (size_t)r * 256 + 4 * lane) = w;
    }
    for (int ch = F.gw; ch < (gr.rows >> 2); ch += F.ngw) {
        const int r0 = ch * 4, pos0 = r0 % gr.L;
        const bf16_t* z0 = Z + (size_t)r0 * 4096;
        const int c0 = 8 * lane;
        u32x2 cw[4];
#pragma unroll
        for (int i = 0; i < 4; ++i) cw[i] = *(const u32x2*)(z0 + (size_t)i * 4096 + 768 + 4 * lane);
        u32x4 bgw[4], cgw[6], xcw[6];
#pragma unroll
        for (int i = 0; i < 4; ++i) bgw[i] = *(const u32x4*)(z0 + (size_t)i * 4096 + 2560 + c0);
#pragma unroll
        for (int j = 0; j < 6; ++j) { const int pr = pos0 - 1 + j; const bool ok = pr >= 0 && pr < gr.L;
            cgw[j] = ok ? *(const u32x4*)(z0 + (ptrdiff_t)(j - 1) * 4096 + 3072 + c0) : (u32x4){0u, 0u, 0u, 0u};
            xcw[j] = ok ? *(const u32x4*)(z0 + (ptrdiff_t)(j - 1) * 4096 + 3584 + c0) : (u32x4){0u, 0u, 0u, 0u}; }
        const int wh = 1 << (lane >> 4);
        u32x4 pw_[19];
#pragma unroll
        for (int j = 0; j < 19; ++j) { const int d = j - 8, pr = pos0 + d; const bool ok = pr >= 0 && pr < gr.L && d >= -wh && d <= wh + 2;
            pw_[j] = ok ? *(const u32x4*)(z0 + (ptrdiff_t)d * 4096 + 1024 + c0) : (u32x4){0u, 0u, 0u, 0u}; }
        { const f32x4 kw4 = *(const f32x4*)(kvan + 4 * lane);
#pragma unroll
          for (int i = 0; i < 4; ++i) { f32x4 v = {bf_lo(cw[i].x), bf_hi(cw[i].x), bf_lo(cw[i].y), bf_hi(cw[i].y)};
            const float ss = wave_sum((v[0] * v[0] + v[1] * v[1]) + (v[2] * v[2] + v[3] * v[3]));
            v = v * rsqrtf(ss * (1.0f / KVL) + EPS) * kw4;
            u32x2 o; o.x = cvt_pk_bf16(v[0], v[1]); o.y = cvt_pk_bf16(v[2], v[3]); *(u32x2*)(CKV + (size_t)(r0 + i) * 256 + 4 * lane) = o;
            if (g == 0) { const int rr = r0 + i, b = rr >> 8, sidx = rr & 255; *(f32x4*)(F.out + (size_t)TALL * DM + ((size_t)(b * 2 + l) * 256 + sidx) * 256 + 4 * lane) = v; } } }
        { float y[6][8];
#pragma unroll
          for (int j = 0; j < 6; ++j) { y[j][0] = bf_lo(cgw[j].x) * bf_lo(xcw[j].x); y[j][1] = bf_hi(cgw[j].x) * bf_hi(xcw[j].x); y[j][2] = bf_lo(cgw[j].y) * bf_lo(xcw[j].y); y[j][3] = bf_hi(cgw[j].y) * bf_hi(xcw[j].y);
              y[j][4] = bf_lo(cgw[j].z) * bf_lo(xcw[j].z); y[j][5] = bf_hi(cgw[j].z) * bf_hi(xcw[j].z); y[j][6] = bf_lo(cgw[j].w) * bf_lo(xcw[j].w); y[j][7] = bf_hi(cgw[j].w) * bf_hi(xcw[j].w); }
          float k0[8], k1[8], k2[8];
#pragma unroll
          for (int q = 0; q < 8; ++q) { k0[q] = convw[c0 + q]; k1[q] = convw[512 + c0 + q]; k2[q] = convw[1024 + c0 + q]; }
#pragma unroll
          for (int i = 0; i < 4; ++i) { const float bgv[8] = {bf_lo(bgw[i].x), bf_hi(bgw[i].x), bf_lo(bgw[i].y), bf_hi(bgw[i].y), bf_lo(bgw[i].z), bf_hi(bgw[i].z), bf_lo(bgw[i].w), bf_hi(bgw[i].w)};
              float o[8];
#pragma unroll
              for (int q = 0; q < 8; ++q) o[q] = bgv[q] * (k0[q] * y[i][q] + k1[q] * y[i + 1][q] + k2[q] * y[i + 2][q]);
              store8(BR + (size_t)(r0 + i) * 2560 + 2048 + c0, o); } }
        { float s[4][8], cnt[4];
#pragma unroll
          for (int i = 0; i < 4; ++i) { cnt[i] = 0.f;
#pragma unroll
              for (int q = 0; q < 8; ++q) s[i][q] = 0.f; }
#pragma unroll
          for (int j = 0; j < 19; ++j) { const int d = j - 8, pr = pos0 + d; const bool inseq = pr >= 0 && pr < gr.L;
              const float x[8] = {bf_lo(pw_[j].x), bf_hi(pw_[j].x), bf_lo(pw_[j].y), bf_hi(pw_[j].y), bf_lo(pw_[j].z), bf_hi(pw_[j].z), bf_lo(pw_[j].w), bf_hi(pw_[j].w)};
#pragma unroll
              for (int i = 0; i < 4; ++i) { if (d - i < -8 || d - i > 7) continue;
                  const float mk = (inseq && d - i >= -wh && d - i <= wh - 1) ? 1.0f : 0.0f; cnt[i] += mk;
#pragma unroll
                  for (int q = 0; q < 8; ++q) s[i][q] += mk * x[q]; } }
#pragma unroll
          for (int i = 0; i < 4; ++i) { const float inv = 1.0f / cnt[i]; const u32x4 w = pw_[8 + i];
              const float x[8] = {bf_lo(w.x), bf_hi(w.x), bf_lo(w.y), bf_hi(w.y), bf_lo(w.z), bf_hi(w.z), bf_lo(w.w), bf_hi(w.w)};
              float o[8];
#pragma unroll
              for (int q = 0; q < 8; ++q) o[q] = s[i][q] * inv - x[q];
              store8(BR + (size_t)(r0 + i) * 2560 + 1024 + c0, o); } }
    }
    {
        constexpr int VS = 272;
        LAS unsigned char* vt = F.lds;
        const bf16_t* WSP = (const bf16_t*)(F.ws + WS_W0 + OFF_WSP);
        const float* sgn = F.in[I_SGUN] + l * 512; const float* bsp = F.in[I_BSP] + l * 512;
        const int nun = (gr.rows >> 7) * 2;
        const int fr = lane & 15, fq = lane >> 4, wq = F.wave >> 1, wcn = F.wave & 1;
        const f32x4 n0 = *(const f32x4*)(sgn + 8 * lane), n1 = *(const f32x4*)(sgn + 8 * lane + 4);
        u32x4 wv[16];
        if (F.bx < nun) { const int r0 = (F.bx >> 1) * 128;
#pragma unroll
            for (int pp = 0; pp < 16; ++pp) wv[pp] = *(const u32x4*)(Z + (size_t)(r0 + 16 * F.wave + pp) * 4096 + 2048 + 8 * lane); }
#define SGU_LOADA(gq_, af_) do { \
            _Pragma("unroll") for (int ks = 0; ks < 4; ++ks) _Pragma("unroll") for (int m = 0; m < 2; ++m) af_[ks][m] = *(const bf16x8*)(WSP + ((size_t)(gq_) * 128 + 32 * wq + 16 * m + fr) * 128 + 32 * ks + 8 * fq); } while (0)
#define SGU_LOADU(gq_, uw_, b0_, b1_) do { \
            _Pragma("unroll") for (int m = 0; m < 2; ++m) _Pragma("unroll") for (int n = 0; n < 4; ++n) uw_[m][n] = *(const u32x2*)(Z + (size_t)(r0 + 32 * wq + 16 * m + fr) * 4096 + 1536 + (gq_) * 128 + 64 * wcn + 16 * n + 4 * fq); \
            b0_ = bsp[(gq_) * 128 + 32 * wq + fr]; b1_ = bsp[(gq_) * 128 + 32 * wq + 16 + fr]; } while (0)
#define SGU_MMA(g2_, af_, acc_) do { \
            _Pragma("unroll") for (int m = 0; m < 2; ++m) _Pragma("unroll") for (int n = 0; n < 4; ++n) acc_[m][n] = (f32x4){0.f, 0.f, 0.f, 0.f}; \
            _Pragma("unroll") for (int ks = 0; ks < 4; ++ks) { bf16x8 bfr[4]; \
                _Pragma("unroll") for (int n = 0; n < 4; ++n) bfr[n] = *(const LAS bf16x8*)(vt + (128 * (g2_) + 64 * wcn + 16 * n + fr) * VS + (((4 * ks + fq) ^ ((2 * n + (fr >> 3)) & 7)) << 4)); \
                _Pragma("unroll") for (int m = 0; m < 2; ++m) _Pragma("unroll") for (int n = 0; n < 4; ++n) acc_[m][n] = __builtin_amdgcn_mfma_f32_16x16x32_bf16(bfr[n], af_[ks][m], acc_[m][n], 0, 0, 0); } } while (0)
#define SGU_EPI(gq_, acc_, uw_, b0_, b1_) do { \
            _Pragma("unroll") for (int m = 0; m < 2; ++m) { const int q = 32 * wq + 16 * m + fr; const float bq = m == 0 ? b0_ : b1_; \
                _Pragma("unroll") for (int n = 0; n < 4; ++n) { const int c = 64 * wcn + 16 * n + 4 * fq; const u32x2 u2 = uw_[m][n]; \
                    const float o0 = gelu_tanh(bf_lo(u2.x)) * (acc_[m][n][0] + bq), o1 = gelu_tanh(bf_hi(u2.x)) * (acc_[m][n][1] + bq), \
                                o2 = gelu_tanh(bf_lo(u2.y)) * (acc_[m][n][2] + bq), o3 = gelu_tanh(bf_hi(u2.y)) * (acc_[m][n][3] + bq); \
                    u32x2 ow; ow.x = cvt_pk_bf16(o0, o1); ow.y = cvt_pk_bf16(o2, o3); \
                    *(u32x2*)(BR + (size_t)(r0 + q) * 2560 + 1536 + (gq_) * 128 + c) = ow; } } } while (0)
        for (int un = F.bx; un < nun; un += F.G) {
            const int ch = un >> 1, gp = un & 1, r0 = ch * 128;
            bf16x8 af[4][2]; u32x2 uwa[2][4], uwb[2][4]; float ba0, ba1, bb0, bb1;
            SGU_LOADA(2 * gp, af); SGU_LOADU(2 * gp, uwa, ba0, ba1);
            __syncthreads();
#pragma unroll
            for (int g4 = 0; g4 < 4; ++g4) {
                float nv[4][8];
#pragma unroll
                for (int q4 = 0; q4 < 4; ++q4) { const u32x4 w = wv[4 * g4 + q4];
                    float v[8] = {bf_lo(w.x), bf_hi(w.x), bf_lo(w.y), bf_hi(w.y), bf_lo(w.z), bf_hi(w.z), bf_lo(w.w), bf_hi(w.w)};
                    float ss = 0.f;
#pragma unroll
                    for (int j = 0; j < 8; ++j) { v[j] = gelu_tanh(v[j]); ss += v[j] * v[j]; }
                    const float rstd = rsqrtf(wave_sum(ss) * (1.0f / 512.0f) + EPS);
#pragma unroll
                    for (int j = 0; j < 8; ++j) nv[q4][j] = v[j] * rstd * (j < 4 ? n0[j & 3] : n1[j & 3]); }
                if ((lane >> 5) == gp) { const int p0 = 16 * F.wave + 4 * g4;
                    LAS unsigned char* dst = vt + 8 * (lane & 31) * VS + ((((p0 >> 3) ^ (lane & 7)) << 4) | ((p0 & 4) << 1));
#pragma unroll
                    for (int j = 0; j < 8; ++j) *(LAS u32x2*)(dst + j * VS) = (u32x2){cvt_pk_bf16(nv[0][j], nv[1][j]), cvt_pk_bf16(nv[2][j], nv[3][j])}; }
                if (un + F.G < nun) { const int r1 = ((un + F.G) >> 1) * 128;
#pragma unroll
                    for (int q4 = 0; q4 < 4; ++q4) wv[4 * g4 + q4] = *(const u32x4*)(Z + (size_t)(r1 + 16 * F.wave + 4 * g4 + q4) * 4096 + 2048 + 8 * lane); }
            }
            __syncthreads();
            f32x4 acc[2][4];
            SGU_LOADU(2 * gp + 1, uwb, bb0, bb1);
            SGU_MMA(0, af, acc);
            SGU_LOADA(2 * gp + 1, af);
            SGU_EPI(2 * gp, acc, uwa, ba0, ba1);
            SGU_MMA(1, af, acc);
            SGU_EPI(2 * gp + 1, acc, uwb, bb0, bb1);
        }
#undef SGU_LOADA
#undef SGU_LOADU
#undef SGU_MMA
#undef SGU_EPI
        __syncthreads();
    }
}

__device__ __forceinline__ void thin_c(Frame& F, int l, int g) {
    const Grp gr = grp_of(g);
    unsigned char* gb = F.ws + WS_G;
    bf16_t* QB = (bf16_t*)(gb + G_Q); const bf16_t* KN = (const bf16_t*)(gb + G_KN); bf16_t* KB = (bf16_t*)(gb + G_K); const bf16_t* Z = (const bf16_t*)(gb + G_Z);
    const bf16_t* KP = (const bf16_t*)(F.ws + WS_KPE);
    const float* qn = F.in[I_QN] + l * QKH; const float* kn = F.in[I_KN] + l * QKH;
    const int lane = F.lane, hd = lane >> 2, j4 = lane & 3;
    const float QSCALE = 0.10206207261596577f * 1.4426950408889634f;
    float qw[32], kw[32];
#pragma unroll
    for (int i = 0; i < 16; ++i) { qw[i] = qn[16 * j4 + i]; kw[i] = kn[16 * j4 + i]; }
#pragma unroll
    for (int i = 0; i < 8; ++i) { qw[16 + i] = qn[64 + 8 * j4 + i]; qw[24 + i] = qn[64 + 8 * (j4 ^ 1) + i]; kw[16 + i] = kn[64 + 8 * j4 + i]; kw[24 + i] = kn[64 + 8 * (j4 ^ 1) + i]; }
    struct Row { u32x4 qa, qb, qo, qp, ka, kb, ko, kp; u32x2 z0, z1, z2; };
#define TC_LOAD(R, r) do { const bf16_t* qp_ = QB + (size_t)(r) * 1536 + hd * QKH; const bf16_t* zr_ = Z + (size_t)(r) * 4096; const bf16_t* kp_ = KN + (size_t)(r) * 1024 + hd * 64; const bf16_t* pe_ = KP + (size_t)(gr.row0 + (r)) * 32; \
        R.qa = *(const u32x4*)(qp_ + 16 * j4); R.qb = *(const u32x4*)(qp_ + 16 * j4 + 8); R.qo = *(const u32x4*)(qp_ + 64 + 8 * j4); R.qp = *(const u32x4*)(qp_ + 64 + 8 * (j4 ^ 1)); \
        R.z0 = *(const u32x2*)(zr_ + 12 * lane); R.z1 = *(const u32x2*)(zr_ + 12 * lane + 4); R.z2 = *(const u32x2*)(zr_ + 12 * lane + 8); \
        R.ka = *(const u32x4*)(kp_ + 16 * j4); R.kb = *(const u32x4*)(kp_ + 16 * j4 + 8); R.ko = *(const u32x4*)(pe_ + 8 * j4); R.kp = *(const u32x4*)(pe_ + 8 * (j4 ^ 1)); } while (0)
#define TC_UNPACK(W_, V_) do { const u32x4 t_ = (W_); V_[0] = bf_lo(t_.x); V_[1] = bf_hi(t_.x); V_[2] = bf_lo(t_.y); V_[3] = bf_hi(t_.y); V_[4] = bf_lo(t_.z); V_[5] = bf_hi(t_.z); V_[6] = bf_lo(t_.w); V_[7] = bf_hi(t_.w); } while (0)
#define TC_ROPE_TAB(pos) float cs[8] = {1.f,1.f,1.f,1.f,1.f,1.f,1.f,1.f}, sn[8] = {0.f,0.f,0.f,0.f,0.f,0.f,0.f,0.f}; \
        if (rope) { const float pv = (float)((j4 >> 1) == 0 ? ((pos) >> 6) : ((pos) & 63)); \
            _Pragma("unroll") for (int f = 0; f < 8; ++f) { const float ang = pv * __builtin_amdgcn_exp2f(-1.6609640474436813f * (float)f); cs[f] = __cosf(ang); sn[f] = __sinf(ang); } }
#define TC_FINISH(a, b, o, p, wv, scale, dst) do { float ss = 0.f; \
        _Pragma("unroll") for (int i = 0; i < 8; ++i) ss += a[i] * a[i] + b[i] * b[i] + o[i] * o[i]; \
        ss = quad_sum(ss); \
        const float rn = rsqrtf(ss * (1.0f / QKH) + EPS) * (scale); \
        _Pragma("unroll") for (int i = 0; i < 8; ++i) { a[i] *= rn * wv[i]; b[i] *= rn * wv[8 + i]; o[i] *= rn * wv[16 + i]; p[i] *= rn * wv[24 + i]; } \
        if (rope) { _Pragma("unroll") for (int i = 0; i < 8; ++i) o[i] = (j4 & 1) ? o[i] * cs[i] + p[i] * sn[i] : o[i] * cs[i] - p[i] * sn[i]; } \
        store8((dst) + 16 * j4, a); store8((dst) + 16 * j4 + 8, b); store8((dst) + 64 + 8 * j4, o); } while (0)
#define TC_COMPUTE(R, r) do { const bool rope = (g != 0); const int pos = (r) % gr.L; TC_ROPE_TAB(pos) \
        float s2 = 0.f; { const float a0 = bf_lo(R.z0.x), a1 = bf_hi(R.z0.x), a2 = bf_lo(R.z0.y), a3 = bf_hi(R.z0.y), a4 = bf_lo(R.z1.x), a5 = bf_hi(R.z1.x), a6 = bf_lo(R.z1.y), a7 = bf_hi(R.z1.y), a8 = bf_lo(R.z2.x), a9 = bf_hi(R.z2.x), a10 = bf_lo(R.z2.y), a11 = bf_hi(R.z2.y); \
            s2 = ((a0 * a0 + a1 * a1) + (a2 * a2 + a3 * a3)) + ((a4 * a4 + a5 * a5) + (a6 * a6 + a7 * a7)) + ((a8 * a8 + a9 * a9) + (a10 * a10 + a11 * a11)); } \
        const float rq = rsqrtf(wave_sum(s2) * (1.0f / QLORA) + EPS); \
        { float a[8], b[8], o[8], p[8]; TC_UNPACK(R.qa, a); TC_UNPACK(R.qb, b); TC_UNPACK(R.qo, o); TC_UNPACK(R.qp, p); \
          _Pragma("unroll") for (int i = 0; i < 8; ++i) { a[i] *= rq; b[i] *= rq; o[i] *= rq; p[i] *= rq; } \
          bf16_t* qd = QB + (size_t)(r) * 1536 + hd * QKH; TC_FINISH(a, b, o, p, qw, QSCALE, qd); } \
        { float a[8], b[8], o[8], p[8]; TC_UNPACK(R.ka, a); TC_UNPACK(R.kb, b); TC_UNPACK(R.ko, o); TC_UNPACK(R.kp, p); \
          bf16_t* kd = KB + (size_t)(r) * 1536 + hd * QKH; TC_FINISH(a, b, o, p, kw, 1.0f, kd); } } while (0)
    {
        Row R0, R1; int r = F.gw;
        if (r < gr.rows) TC_LOAD(R0, r);
        for (; r < gr.rows; r += 2 * F.ngw) {
            const int r1 = r + F.ngw, r2 = r + 2 * F.ngw;
            if (r1 < gr.rows) TC_LOAD(R1, r1);
            TC_COMPUTE(R0, r);
            if (r2 < gr.rows) TC_LOAD(R0, r2);
            if (r1 < gr.rows) TC_COMPUTE(R1, r1);
        }
    }
    for (int r = gr.rows + F.gw; r < gr.tkv; r += F.ngw) {
        const bool rope = false; float cs[8] = {1.f,1.f,1.f,1.f,1.f,1.f,1.f,1.f}, sn[8] = {0.f,0.f,0.f,0.f,0.f,0.f,0.f,0.f};
        const bf16_t* kp = KN + (size_t)r * 1024 + hd * 64;
        float a[8], b[8], o[8], p[8];
        load8(kp + 16 * j4, a); load8(kp + 16 * j4 + 8, b);
        { const int ci = r - gr.rows, sq = ci >> 8, pp = ci & 255, bb = 4 * (g - 1) + sq; const float* pe = F.in[I_CKPE] + (((size_t)bb * 2 + l) * 256 + pp) * 32;
#pragma unroll
          for (int i = 0; i < 8; ++i) { o[i] = pe[8 * j4 + i]; p[i] = pe[8 * (j4 ^ 1) + i]; } }
        bf16_t* kd = KB + (size_t)r * 1536 + hd * QKH; TC_FINISH(a, b, o, p, kw, 1.0f, kd);
    }
#undef TC_LOAD
#undef TC_UNPACK
#undef TC_ROPE_TAB
#undef TC_FINISH
#undef TC_COMPUTE
}

__device__ __forceinline__ void attn_phase(Frame& F, int g) {
    const Grp gr = grp_of(g);
    unsigned char* gb = F.ws + WS_G;
    const bf16_t* Q = (const bf16_t*)(gb + G_Q); const bf16_t* K = (const bf16_t*)(gb + G_K); const bf16_t* VT = (const bf16_t*)(gb + G_VT); bf16_t* BR = (bf16_t*)(gb + G_BR);
    constexpr int KS = 208, VS = 136, KBUF = 64 * KS, VBUF = 64 * VS;
    LAS unsigned char* kl = F.lds; LAS unsigned char* vl = F.lds + 2 * KBUF;
    const int tid = F.tid, lane = F.lane, wid = F.wave, r32 = lane & 31, hh = lane >> 5;
    const bool late = wid >= 4;
    const int qblocks = gr.L >> 8, nunits = gr.nseq * NH * qblocks, ntl = gr.L >> 6, nt = (gr.L + gr.C) >> 6;
    const int vcu = (F.G & 7) == 0 ? (F.bx & 7) * (F.G >> 3) + (F.bx >> 3) : F.bx;
    const int k0key = tid / 12, k0part = tid % 12, k1key = (tid + 512) / 12, k1part = (tid + 512) % 12; const bool k1v = tid < 256;
    const int vd = tid >> 3, vpart = tid & 7;
#define ATT_LOADG(t, Kh_, Vh_, srow0_, crow0_, kr0, kr1, vr) do { if ((t) < nt) { const int kb_ = (t) < ntl ? (srow0_) + 64 * (t) : (crow0_) + 64 * ((t) - ntl); \
        kr0 = *(const u32x4*)((Kh_) + (size_t)(kb_ + k0key) * 1536 + 8 * k0part); if (k1v) kr1 = *(const u32x4*)((Kh_) + (size_t)(kb_ + k1key) * 1536 + 8 * k1part); \
        vr = *(const u32x4*)((Vh_) + kb_); } } while (0)
#define ATT_UNIT_IDX(u_, qb_, head_, srow0_, crow0_) const int qb_ = (u_) % qblocks, sh##qb_ = (u_) / qblocks, head_ = sh##qb_ % NH, sq##qb_ = sh##qb_ / NH, srow0_ = sq##qb_ * gr.L, crow0_ = gr.rows + sq##qb_ * gr.C
#define ATT_QLOAD(qb_, head_, srow0_) do { const bf16_t* qp_ = Q + (size_t)((srow0_) + 256 * (qb_) + 32 * wid + r32) * 1536 + (head_) * QKH + 8 * hh; \
        _Pragma("unroll") for (int s = 0; s < 6; ++s) qf[s] = *(const bf16x8*)(qp_ + 16 * s); } while (0)
    bf16x8 qf[6];
    u32x4 ka0, ka1 = {0u, 0u, 0u, 0u}, va_, kb0, kb1 = {0u, 0u, 0u, 0u}, vb_;
    volatile LAS unsigned* flagw = (volatile LAS unsigned*)(F.lds + LDS_MISC) + 48;
    if (tid == 0) { flagw[0] = 0u; flagw[1] = 0u; }
    if (vcu < nunits) { ATT_UNIT_IDX(vcu, qb0, head0, srow00, crow00);
        ATT_LOADG(0, K + head0 * QKH, VT + (size_t)(head0 * 64 + vd) * gr.tkv + 8 * vpart, srow00, crow00, ka0, ka1, va_); }
    unsigned par = 0;
    for (int un = vcu; un < nunits; un += F.G, par ^= 1u) {
        ATT_UNIT_IDX(un, qb, head, srow0, crow0);
        const bf16_t* Kh = K + head * QKH; const bf16_t* Vh = VT + (size_t)(head * 64 + vd) * gr.tkv + 8 * vpart;
        ATT_QLOAD(qb, head, srow0);
#define ATT_LOAD(t, kr0, kr1, vr) ATT_LOADG(t, Kh, Vh, srow0, crow0, kr0, kr1, vr)
#define ATT_STORE(t, kbo, vbo, kr0, kr1, vr) do { if ((t) < nt) { *(LAS u32x4*)(kl + (kbo) + k0key * KS + 16 * k0part) = kr0; if (k1v) *(LAS u32x4*)(kl + (kbo) + k1key * KS + 16 * k1part) = kr1; \
        *(LAS u32x2*)(vl + (vbo) + vd * VS + 16 * vpart) = (u32x2){vr.x, vr.y}; *(LAS u32x2*)(vl + (vbo) + vd * VS + 16 * vpart + 8) = (u32x2){vr.z, vr.w}; } } while (0)
        const f32x16 z16 = {0.f,0.f,0.f,0.f,0.f,0.f,0.f,0.f,0.f,0.f,0.f,0.f,0.f,0.f,0.f,0.f};
        float m_run, l_run, ts_prev; bool first;
        f32x16 negm, o0, o1, p0, p1;
        u32x4 pw[2][2];
#define ATT_X(kbo) do { LAS unsigned char* kb = kl + (kbo); \
            _Pragma("unroll") for (int s = 0; s < 6; ++s) { \
                const bf16x8 ka = *(const LAS bf16x8*)(kb + r32 * KS + 32 * s + 16 * hh), kc = *(const LAS bf16x8*)(kb + (32 + r32) * KS + 32 * s + 16 * hh); \
                p0 = __builtin_amdgcn_mfma_f32_32x32x16_bf16(ka, qf[s], s == 0 ? negm : p0, 0, 0, 0); p1 = __builtin_amdgcn_mfma_f32_32x32x16_bf16(kc, qf[s], s == 0 ? negm : p1, 0, 0, 0); } } while (0)
#define ATT_YS() do { float mx = p0[0]; \
            _Pragma("unroll") for (int i = 1; i < 16; ++i) mx = fmaxf(mx, p0[i]); \
            _Pragma("unroll") for (int i = 0; i < 16; ++i) mx = fmaxf(mx, p1[i]); \
            { auto rr = __builtin_amdgcn_permlane32_swap(__float_as_uint(mx), __float_as_uint(mx), false, false); mx = fmaxf(__uint_as_float(rr[0]), __uint_as_float(rr[1])); } \
            if (first || __builtin_amdgcn_ballot_w64(mx > 5.0f) != 0ull) {            \
                const float dl = first ? mx : fmaxf(mx, 0.f); const float al = __builtin_amdgcn_exp2f(-dl); \
                m_run += dl; l_run *= al; o0 *= al; o1 *= al; p0 = p0 - dl; p1 = p1 - dl; \
                _Pragma("unroll") for (int i = 0; i < 16; ++i) negm[i] = -m_run; first = false; } \
            _Pragma("unroll") for (int i = 0; i < 16; ++i) { p0[i] = __builtin_amdgcn_exp2f(p0[i]); p1[i] = __builtin_amdgcn_exp2f(p1[i]); } \
            { const f32x16 s16 = p0 + p1; \
              const f32x4 s4 = (f32x4){s16[0], s16[1], s16[2], s16[3]} + (f32x4){s16[4], s16[5], s16[6], s16[7]} + (f32x4){s16[8], s16[9], s16[10], s16[11]} + (f32x4){s16[12], s16[13], s16[14], s16[15]}; \
              l_run += (s4[0] + s4[1]) + (s4[2] + s4[3]); } \
            _Pragma("unroll") for (int s2 = 0; s2 < 2; ++s2) { \
                pw[0][s2] = (u32x4){cvt_pk_bf16(p0[8 * s2], p0[8 * s2 + 1]), cvt_pk_bf16(p0[8 * s2 + 2], p0[8 * s2 + 3]), cvt_pk_bf16(p0[8 * s2 + 4], p0[8 * s2 + 5]), cvt_pk_bf16(p0[8 * s2 + 6], p0[8 * s2 + 7])}; \
                pw[1][s2] = (u32x4){cvt_pk_bf16(p1[8 * s2], p1[8 * s2 + 1]), cvt_pk_bf16(p1[8 * s2 + 2], p1[8 * s2 + 3]), cvt_pk_bf16(p1[8 * s2 + 4], p1[8 * s2 + 5]), cvt_pk_bf16(p1[8 * s2 + 6], p1[8 * s2 + 7])}; } } while (0)
#define ATT_YF() do { \
            if (first) { float mx = p0[0]; \
                _Pragma("unroll") for (int i = 1; i < 16; ++i) mx = fmaxf(mx, p0[i]); \
                _Pragma("unroll") for (int i = 0; i < 16; ++i) mx = fmaxf(mx, p1[i]); \
                { auto rr = __builtin_amdgcn_permlane32_swap(__float_as_uint(mx), __float_as_uint(mx), false, false); mx = fmaxf(__uint_as_float(rr[0]), __uint_as_float(rr[1])); } \
                m_run = mx; p0 = p0 - mx; p1 = p1 - mx; \
                _Pragma("unroll") for (int i = 0; i < 16; ++i) negm[i] = -m_run; first = false; } \
            else if (__builtin_amdgcn_ballot_w64(!(ts_prev < ATT_BIG)) != 0ull) { \
                float tsr; { auto rr = __builtin_amdgcn_permlane32_swap(__float_as_uint(ts_prev), __float_as_uint(ts_prev), false, false); tsr = __uint_as_float(rr[0]) + __uint_as_float(rr[1]); }     \
                const float dl = !(tsr < ATT_BIG) ? (float)((int)((__float_as_uint(tsr) >> 23) & 255u) - 127) : 0.f; const float al = __builtin_amdgcn_exp2f(-dl); \
                m_run += dl; l_run *= al; o0 *= al; o1 *= al; p0 = p0 - dl; p1 = p1 - dl; \
                _Pragma("unroll") for (int i = 0; i < 16; ++i) negm[i] = -m_run; } \
            _Pragma("unroll") for (int i = 0; i < 16; ++i) { p0[i] = __builtin_amdgcn_exp2f(p0[i]); p1[i] = __builtin_amdgcn_exp2f(p1[i]); } \
            { const f32x16 s16 = p0 + p1; \
              const f32x4 s4 = (f32x4){s16[0], s16[1], s16[2], s16[3]} + (f32x4){s16[4], s16[5], s16[6], s16[7]} + (f32x4){s16[8], s16[9], s16[10], s16[11]} + (f32x4){s16[12], s16[13], s16[14], s16[15]}; \
              ts_prev = (s4[0] + s4[1]) + (s4[2] + s4[3]); l_run += ts_prev; } \
            _Pragma("unroll") for (int s2 = 0; s2 < 2; ++s2) { \
                pw[0][s2] = (u32x4){cvt_pk_bf16(p0[8 * s2], p0[8 * s2 + 1]), cvt_pk_bf16(p0[8 * s2 + 2], p0[8 * s2 + 3]), cvt_pk_bf16(p0[8 * s2 + 4], p0[8 * s2 + 5]), cvt_pk_bf16(p0[8 * s2 + 6], p0[8 * s2 + 7])}; \
                pw[1][s2] = (u32x4){cvt_pk_bf16(p1[8 * s2], p1[8 * s2 + 1]), cvt_pk_bf16(p1[8 * s2 + 2], p1[8 * s2 + 3]), cvt_pk_bf16(p1[8 * s2 + 4], p1[8 * s2 + 5]), cvt_pk_bf16(p1[8 * s2 + 6], p1[8 * s2 + 7])}; } } while (0)
#define ATT_Z(vbo) do { LAS unsigned char* vb = vl + (vbo); \
            _Pragma("unroll") for (int kbk = 0; kbk < 2; ++kbk) \
            _Pragma("unroll") for (int s2 = 0; s2 < 2; ++s2) { const int kbase = (32 * kbk + 16 * s2 + 4 * hh) * 2; \
                    const u32x2 a0 = *(const LAS u32x2*)(vb + r32 * VS + kbase), a1 = *(const LAS u32x2*)(vb + r32 * VS + kbase + 16); \
                    const u32x2 c0 = *(const LAS u32x2*)(vb + (32 + r32) * VS + kbase), c1 = *(const LAS u32x2*)(vb + (32 + r32) * VS + kbase + 16); \
                    const u32x4 va = {a0.x, a0.y, a1.x, a1.y}, vc = {c0.x, c0.y, c1.x, c1.y}; \
                    const bf16x8 pb = __builtin_bit_cast(bf16x8, pw[kbk][s2]); \
                    o0 = __builtin_amdgcn_mfma_f32_32x32x16_bf16(__builtin_bit_cast(bf16x8, va), pb, o0, 0, 0, 0); \
                    o1 = __builtin_amdgcn_mfma_f32_32x32x16_bf16(__builtin_bit_cast(bf16x8, vc), pb, o1, 0, 0, 0); } } while (0)
        int kcur, vprev, vcur, vnext;
#define ATT_ROT() do { kcur ^= KBUF; vprev = vcur; vcur = vnext; vnext = (vnext == 2 * VBUF) ? 0 : vnext + VBUF; } while (0)
#define ATT_UNIT(YM) do { m_run = 0.f; l_run = 0.f; ts_prev = 0.f; first = true; negm = z16; o0 = z16; o1 = z16; p0 = z16; p1 = z16; \
        ATT_STORE(0, 0, 0, ka0, ka1, va_); ATT_LOAD(1, kb0, kb1, vb_); \
        __syncthreads(); \
        kcur = 0; vprev = 2 * VBUF; vcur = 0; vnext = VBUF; \
        if (!late) { \
            for (int t = 0; t < nt; t += 2) { \
                ATT_LOAD(t + 2, ka0, ka1, va_); \
                ATT_X(kcur); YM(); ATT_Z(vcur); \
                ATT_STORE(t + 1, kcur ^ KBUF, vnext, kb0, kb1, vb_); \
                __syncthreads(); ATT_ROT(); \
                ATT_LOAD(t + 3, kb0, kb1, vb_); \
                ATT_X(kcur); YM(); ATT_Z(vcur); \
                ATT_STORE(t + 2, kcur ^ KBUF, vnext, ka0, ka1, va_); \
                __syncthreads(); ATT_ROT(); \
            } \
        } else { \
            for (int t = 0; t < nt; t += 2) { \
                ATT_LOAD(t + 2, ka0, ka1, va_); \
                if (t > 0) { YM(); ATT_Z(vprev); } \
                ATT_X(kcur); \
                ATT_STORE(t + 1, kcur ^ KBUF, vnext, kb0, kb1, vb_); \
                __syncthreads(); ATT_ROT(); \
                ATT_LOAD(t + 3, kb0, kb1, vb_); \
                YM(); ATT_Z(vprev); \
                ATT_X(kcur); \
                ATT_STORE(t + 2, kcur ^ KBUF, vnext, ka0, ka1, va_); \
                __syncthreads(); ATT_ROT(); \
            } \
            YM(); ATT_Z(vprev); \
        } \
        } while (0)
        ATT_UNIT(ATT_YF);
#define ATT_PREFETCH_NEXT() do { if (un + F.G < nunits) { ATT_UNIT_IDX(un + F.G, qbn, headn, srow0n, crow0n); \
            ATT_LOADG(0, K + headn * QKH, VT + (size_t)(headn * 64 + vd) * gr.tkv + 8 * vpart, srow0n, crow0n, ka0, ka1, va_); } } while (0)
        ATT_PREFETCH_NEXT();
        {
            float chk = l_run;
#pragma unroll
            for (int i = 0; i < 16; ++i) chk += __builtin_fabsf(o0[i]) + __builtin_fabsf(o1[i]);
            if (__builtin_amdgcn_ballot_w64(!(chk < ATT_CHK)) != 0ull && lane == 0) flagw[par] = 1u;
            __syncthreads();
            const unsigned redo = flagw[par];
            if (tid == 0) flagw[par ^ 1u] = 0u;
            if (redo) { ATT_LOAD(0, ka0, ka1, va_); ATT_UNIT(ATT_YS); ATT_PREFETCH_NEXT(); __syncthreads(); }
        }
#undef ATT_PREFETCH_NEXT
#undef ATT_ROT
#undef ATT_LOAD
#undef ATT_STORE
#undef ATT_X
#undef ATT_YS
#undef ATT_YF
#undef ATT_UNIT
#undef ATT_Z
        { auto rr = __builtin_amdgcn_permlane32_swap(__float_as_uint(l_run), __float_as_uint(l_run), false, false); l_run = __uint_as_float(rr[0]) + __uint_as_float(rr[1]); }
        const float il = 1.0f / l_run;
        bf16_t* op = BR + (size_t)(srow0 + 256 * qb + 32 * wid + r32) * 2560 + head * 64;
#pragma unroll
        for (int gq = 0; gq < 4; ++gq) { const int d0 = 8 * gq + 4 * hh;
            u32x2 w0; w0.x = cvt_pk_bf16(o0[4 * gq] * il, o0[4 * gq + 1] * il); w0.y = cvt_pk_bf16(o0[4 * gq + 2] * il, o0[4 * gq + 3] * il); *(u32x2*)(op + d0) = w0;
            u32x2 w1; w1.x = cvt_pk_bf16(o1[4 * gq] * il, o1[4 * gq + 1] * il); w1.y = cvt_pk_bf16(o1[4 * gq + 2] * il, o1[4 * gq + 3] * il); *(u32x2*)(op + 32 + d0) = w1; }
    }
    __syncthreads();
#undef ATT_LOADG
#undef ATT_UNIT_IDX
#undef ATT_QLOAD
}

constexpr int STEPS_PER_GROUP = 7, STEPS_PER_LAYER = 2 + NGRP * STEPS_PER_GROUP + 3, NSTEPS = NLAYER * STEPS_PER_LAYER;

__global__ void __launch_bounds__(NTHR, 2) mk_fwd(Args args) {
    extern __shared__ __attribute__((aligned(16))) unsigned char lds_raw[];
    Frame F;
    F.lds = (LAS unsigned char*)lds_raw;
    F.tid = threadIdx.x; F.lane = F.tid & 63; F.wave = __builtin_amdgcn_readfirstlane(F.tid >> 6);
    F.bx = blockIdx.x; F.G = gridDim.x; F.gw = F.bx * NWAVE + F.wave; F.ngw = F.G * NWAVE;
    F.in = args.in; F.out = args.out; F.ws = args.ws;
    volatile LAS unsigned* misc = (volatile LAS unsigned*)(F.lds + LDS_MISC);
    if (F.tid < 64) misc[F.tid] = 0u;
    __syncthreads();
    XcdBarrier bar; bar.bar = (unsigned*)(F.ws + WS_CTL) + 1024; bar.x = 0; bar.st = misc + 8;
#if !MK_MULTI
    bar = xcd_barrier_post((unsigned*)(F.ws + WS_CTL) + 1024, misc + 8);
#endif
    const int lo = args.step_lo, hi = args.step_hi;
#define IN(s) (lo <= (s) && (s) < hi)
#if MK_MULTI
#define SEAM(s) do { } while (0)
#else
#define SEAM(s) do { if (IN(s) && IN((s) + 1)) xcd_barrier(bar); } while (0)
#endif
    for (int l0 = 0; l0 < NLAYER; ++l0) {
        const int sp = l0 * STEPS_PER_LAYER, sl = sp + 1;
        if (IN(sp)) { Frame P = fresh(F); int l = l0; LAUNDER_S(l); p0_prologue(P, l); } SEAM(sp);
        if (IN(sl)) { { Frame P = fresh(F); int l = l0; LAUNDER_S(l);
            if (l == 0) thin_norm<true, false>(P, l, P.in[I_XP], P.in[I_XS], P.in[I_NMIX] + l * DM, 0, 1);
            else thin_norm<true, true>(P, l, nullptr, nullptr, P.in[I_NMIX] + l * DM, 0, 1); } } SEAM(sl);
        for (int g0 = 0; g0 < NGRP; ++g0) {
            const int sg = sl + 1 + g0 * STEPS_PER_GROUP;
            if (IN(sg + 0)) { {
                Frame P = fresh(F); int l = l0, g = g0; LAUNDER_S(l); LAUNDER_S(g); const Grp gr = grp_of(g);
                unsigned char* wl = P.ws + WS_W0; unsigned char* gb = P.ws + WS_G;
                pg8::Prob p{(const bf16_t*)(P.ws + WS_H) + (size_t)gr.row0 * DM, (const bf16_t*)(wl + OFF_WIN), DM, DM, DM};
                pg8::StaticOrder S; S.init(gr.rows, 12288, P.G, P.bx, WGM_BIG);
                pg8::EpiZ E{(bf16_t*)(gb + G_Z), (bf16_t*)(gb + G_GATE), P.in[I_BGATE] + (size_t)l * 8192};
                pg8::gemm_phase(P.lds, p, S, E);
            } } SEAM(sg + 0);
            if (IN(sg + 1)) { { Frame P = fresh(F); int l = l0, g = g0; LAUNDER_S(l); LAUNDER_S(g); thin_b(P, l, g); } } SEAM(sg + 1);
            if (IN(sg + 2)) { {
                Frame P = fresh(F); int l = l0, g = g0; LAUNDER_S(l); LAUNDER_S(g); const Grp gr = grp_of(g);
                unsigned char* wl = P.ws + WS_W0; unsigned char* gb = P.ws + WS_G;
                { pg8::Prob p{(const bf16_t*)(gb + G_Z), (const bf16_t*)(wl + OFF_WUQ), 4096, QLORA, QLORA};
                  pg8::StaticOrder S; S.init(gr.rows, 1536, P.G, P.bx);
                  pg8::EpiStore E{(bf16_t*)(gb + G_Q), 1536};
                  pg8::gemm_phase(P.lds, p, S, E); }
                { pg8::Prob p{(const bf16_t*)(gb + G_CKV), (const bf16_t*)(wl + OFF_WUK), KVL, KVL, KVL};
                  pg8::StaticOrder S; S.init(gr.tkv, 1024, P.G, (P.bx + (g == 0 ? 160 : 128)) % P.G);
                  pg8::EpiStore E{(bf16_t*)(gb + G_KN), 1024};
                  pg8::gemm_phase(P.lds, p, S, E); }
                { pg8::Prob p{(const bf16_t*)(wl + OFF_WUV), (const bf16_t*)(gb + G_CKV), KVL, KVL, KVL};
                  pg8::StaticOrder S; S.init(1024, gr.tkv, P.G, (P.bx + (g == 0 ? 96 : 112)) % P.G);
                  pg8::EpiStore E{(bf16_t*)(gb + G_VT), gr.tkv};
                  pg8::gemm_phase(P.lds, p, S, E); }
            } } SEAM(sg + 2);
            if (IN(sg + 3)) { Frame P = fresh(F); int l = l0, g = g0; LAUNDER_S(l); LAUNDER_S(g); thin_c(P, l, g); } SEAM(sg + 3);
            if (IN(sg + 4)) { { Frame P = fresh(F); int g = g0; LAUNDER_S(g); attn_phase(P, g); } } SEAM(sg + 4);
            if (IN(sg + 5)) { {
                Frame P = fresh(F); int l = l0, g = g0; LAUNDER_S(l); LAUNDER_S(g); const Grp gr = grp_of(g);
                unsigned char* wl = P.ws + WS_W0; unsigned char* gb = P.ws + WS_G;
                pg8::ProbSeg p{(const bf16_t*)(gb + G_BR), (const bf16_t*)(wl + OFF_WBR), 2560, 2560};
                pg8::SegOrder S; S.init(gr.rows, DM, P.G, P.bx, WGM_SMALL);
                pg8::EpiMerge E{(const unsigned char*)(gb + G_GATE), (bf16_t*)(gb + G_M)};
                pg8::gemm_phase(P.lds, p, S, E);
            } } SEAM(sg + 5);
            if (IN(sg + 6)) {
                Frame P = fresh(F); int l = l0, g = g0; LAUNDER_S(l); LAUNDER_S(g); const Grp gr = grp_of(g);
                unsigned char* wl = P.ws + WS_W0; unsigned char* gb = P.ws + WS_G;
                const float* xc = l == 0 ? P.in[I_XP] : nullptr; const float* xl = l == 0 ? P.in[I_XS] : nullptr;
                const float* modl = (const float*)(P.ws + WS_MOD) + (size_t)l * NCOND * 12288;
                pg8::Prob p{(const bf16_t*)(gb + G_M), (const bf16_t*)(wl + OFF_WOUT), DM, DM, DM};
                pg8::StaticOrder S; S.init(gr.rows, DM, P.G, P.bx, WGM_SMALL);
                pg8::EpiResid E{xc, xl, (bf16_t*)(P.ws + WS_XB), nullptr, modl, 2, gr.row0};
                pg8::gemm_phase(P.lds, p, S, E);
            } SEAM(sg + 6);
        }
        const int sf = sl + 1 + NGRP * STEPS_PER_GROUP;
        if (IN(sf)) { { Frame P = fresh(F); int l = l0; LAUNDER_S(l);
            thin_norm<false, true>(P, l, nullptr, nullptr, P.in[I_NFFN] + l * DM, 3, 4); } } SEAM(sf);
        if (IN(sf + 1)) { {
            Frame P = fresh(F); int l = l0; LAUNDER_S(l); unsigned char* wl = P.ws + WS_W0;
            pg8::Prob p{(const bf16_t*)(P.ws + WS_H), (const bf16_t*)(wl + OFF_WFI), DM, DM, DM};
            pg8::StaticOrder S; S.init(TALL, 2 * DFF, P.G, P.bx, WGM_BIG);
            pg8::EpiSwiglu E{(bf16_t*)(P.ws + WS_ACT)};
            pg8::gemm_phase(P.lds, p, S, E);
        } } SEAM(sf + 1);
        if (IN(sf + 2)) {
            Frame P = fresh(F); int l = l0; LAUNDER_S(l); unsigned char* wl = P.ws + WS_W0; float* OUT = P.out;
            const float* modl = (const float*)(P.ws + WS_MOD) + (size_t)l * NCOND * 12288;
            pg8::Prob p{(const bf16_t*)(P.ws + WS_ACT), (const bf16_t*)(wl + OFF_WFO), DFF, DFF, DFF};
            pg8::StaticOrder S; S.init(TALL, DM, P.G, P.bx, WGM_SMALL);
            pg8::EpiResid E{nullptr, nullptr, (bf16_t*)(P.ws + WS_XB), l == NLAYER - 1 ? OUT : nullptr, modl, 5, 0};
            pg8::gemm_phase(P.lds, p, S, E);
        } SEAM(sf + 2);
    }
#undef IN
#undef SEAM
}

extern "C" void kernel_launch(void* const* d_in, const int* in_sizes, int n_in, void* d_out, int out_size, void* d_ws, size_t ws_size, hipStream_t stream) {
    static int grid = 0;
    if (grid == 0) {
        if (n_in != 31 || ws_size < WS_END) { fprintf(stderr, "kernel_launch: n_in %d ws %zu (need %zu)\n", n_in, ws_size, (size_t)WS_END); grid = -1; return; }
        int dev = 0, cus = 0;
        if (hipGetDevice(&dev) != hipSuccess || hipDeviceGetAttribute(&cus, hipDeviceAttributeMultiprocessorCount, dev) != hipSuccess) { grid = -1; return; }
        if (hipFuncSetAttribute((const void*)mk_fwd, hipFuncAttributeMaxDynamicSharedMemorySize, LDS_BYTES) != hipSuccess) { fprintf(stderr, "hipFuncSetAttribute failed\n"); grid = -1; return; }
        int per_cu = 0;
        (void)hipOccupancyMaxActiveBlocksPerMultiprocessor(&per_cu, (const void*)mk_fwd, NTHR, LDS_BYTES);
        (void)hipGetLastError();
        grid = cus < NWG ? cus : NWG;
        if (grid != NWG) fprintf(stderr, "kernel_launch: %d CUs, expected 256\n", cus);
    }
    if (grid < 0) return;
    (void)hipMemsetAsync((char*)d_ws + WS_CTL, 0, CTL_BYTES, stream);
    Args a{};
    for (int i = 0; i < 31; ++i) a.in[i] = (const float*)d_in[i];
    a.out = (float*)d_out; a.ws = (unsigned char*)d_ws;
#if MK_MULTI
    for (int s = 0; s < NSTEPS; ++s) { a.step_lo = s; a.step_hi = s + 1; hipLaunchKernelGGL(mk_fwd, dim3(grid), dim3(NTHR), LDS_BYTES, stream, a); }
#else
    a.step_lo = 0; a.step_hi = NSTEPS;
    hipLaunchKernelGGL(mk_fwd, dim3(grid), dim3(NTHR), LDS_BYTES, stream, a);
#endif
}
```
